# Optimizing an MI355X kernel written in HIP

```python
import math
import jax
import jax.numpy as jnp
from jax import lax
import numpy as np

D_MODEL = 4096
BATCH = 4
SEQ = 4096
DEPTH = 1

CHUNK = 64
Q_BLOCK = 128
EPS = 1e-6

DIFF_HEAD_DIM = 128
DIFF_V_DIM = 2 * DIFF_HEAD_DIM
DIFF_HEADS = D_MODEL // (4 * DIFF_HEAD_DIM)
DIFF_QK_COLS = DIFF_HEADS * 2 * DIFF_HEAD_DIM
DIFF_WIDTH = DIFF_HEADS * DIFF_V_DIM

HG_DK = 128
HG_DV = 128
HG_HEADS = D_MODEL // (2 * HG_DK)
HG_WIDTH = HG_HEADS * HG_DK
HG_V_WIDTH = HG_HEADS * HG_DV

IN_SPLITS = (DIFF_QK_COLS, DIFF_QK_COLS, DIFF_WIDTH, HG_WIDTH, HG_WIDTH, HG_V_WIDTH, HG_V_WIDTH)
IN_COLS = sum(IN_SPLITS)
MIX_WIDTH = DIFF_WIDTH + HG_V_WIDTH

MEM_LEN = 256
MEM_HEADS = 4
MEM_HEAD_DIM = 128
MEM_WIDTH = MEM_HEADS * MEM_HEAD_DIM

PEER_HEADS = 8
PEER_N_KEYS = 128
PEER_N_EXPERTS = PEER_N_KEYS * PEER_N_KEYS
PEER_QDIM = 256
PEER_HALF = PEER_QDIM // 2
PEER_TOPK = 16
PEER_TOKEN_BLOCK = 64

kernel_name = 'hybrid_diffattn_hgrn2_peer_block'


def rms_norm(x, gain):
    xf = x.astype(jnp.float32)
    y = xf * lax.rsqrt(jnp.mean(xf * xf, axis=-1, keepdims=True) + EPS)
    return (y * gain.astype(jnp.float32)).astype(x.dtype)


def chunk_causal_mask(q_pos, k_pos):
    return k_pos[None, :] < ((q_pos // CHUNK + 1) * CHUNK)[:, None]


def diff_attention(q, k, v, lam):
    B, S = q.shape[:2]
    nqb = S // Q_BLOCK
    qb = q.reshape(B, nqb, Q_BLOCK, DIFF_HEADS, 2, DIFF_HEAD_DIM).transpose(1, 0, 2, 3, 4, 5)
    k_pos = jnp.arange(S)
    scale = DIFF_HEAD_DIM ** -0.5

    def block(args):
        q_blk, blk_idx = args
        s = jnp.einsum('bqhmd,bkhmd->bhmqk', q_blk, k).astype(jnp.float32) * scale
        q_pos = blk_idx * Q_BLOCK + jnp.arange(Q_BLOCK)
        mask = chunk_causal_mask(q_pos, k_pos)
        p = jax.nn.softmax(jnp.where(mask, s, -jnp.inf), axis=-1)
        a = p[:, :, 0] - lam * p[:, :, 1]
        return jnp.einsum('bhqk,bkhe->bqhe', a, v)

    out = lax.map(block, (qb, jnp.arange(nqb)))
    return out.transpose(1, 0, 2, 3, 4).reshape(B, S, DIFF_HEADS, DIFF_V_DIM)


def hgrn2_chunkwise(q, k, v, log_f):
    B, S, H, DK = q.shape
    DV = v.shape[-1]
    nc = S // CHUNK

    def to_chunks(t):
        return t.reshape(B, nc, CHUNK, H, t.shape[-1]).transpose(1, 0, 3, 2, 4)

    causal = jnp.tril(jnp.ones((CHUNK, CHUNK), dtype=bool))

    def step(state, inp):
        q_c, k_c, v_c, g_c = inp
        b = jnp.cumsum(g_c, axis=2)
        inter = jnp.einsum('bhtk,bhkv->bhtv', q_c * jnp.exp(b), state)
        rel = b[:, :, :, None, :] - b[:, :, None, :, :]
        decay = jnp.exp(jnp.where(causal[:, :, None], rel, -jnp.inf))
        scores = jnp.einsum('bhtk,bhsk,bhtsk->bhts', q_c, k_c, decay)
        intra = jnp.einsum('bhts,bhsv->bhtv', scores, v_c)
        b_last = b[:, :, -1:, :]
        new_state = (state * jnp.exp(b_last)[:, :, 0, :, None]
                     + jnp.einsum('bhsk,bhsv->bhkv', k_c * jnp.exp(b_last - b), v_c))
        return new_state, inter + intra

    s0 = jnp.zeros((B, H, DK, DV), jnp.float32)
    _, o = lax.scan(step, s0, (to_chunks(q), to_chunks(k), to_chunks(v), to_chunks(log_f)))
    return o.transpose(1, 0, 3, 2, 4).reshape(B, S, H, DV)


def memory_cross_attention(h, mem_n, w_q, w_k, w_v, w_o, q_gain, k_gain):
    B, S, _ = h.shape
    M = mem_n.shape[1]
    q = rms_norm((h @ w_q).reshape(B, S, MEM_HEADS, MEM_HEAD_DIM), q_gain)
    k = rms_norm((mem_n @ w_k).reshape(B, M, MEM_HEADS, MEM_HEAD_DIM), k_gain)
    v = (mem_n @ w_v).reshape(B, M, MEM_HEADS, MEM_HEAD_DIM)
    s = jnp.einsum('bqhd,bmhd->bhqm', q, k).astype(jnp.float32) * (MEM_HEAD_DIM ** -0.5)
    p = jax.nn.softmax(s, axis=-1)
    o = jnp.einsum('bhqm,bmhd->bqhd', p, v.astype(jnp.float32)).reshape(B, S, MEM_WIDTH)
    return o.astype(h.dtype) @ w_o


def peer_ffn(h, w_q, sub_keys, u_tab, v_tab):
    B, S, D = h.shape
    q = (h @ w_q).reshape(B, S, PEER_HEADS, 2, PEER_HALF)
    sc = jnp.einsum('bshpd,hpnd->bshpn', q, sub_keys).astype(jnp.float32)
    half_s, half_i = lax.top_k(sc, PEER_TOPK)
    cand = half_s[..., 0, :, None] + half_s[..., 1, None, :]
    best_s, best_pos = lax.top_k(cand.reshape(B, S, PEER_HEADS, PEER_TOPK * PEER_TOPK), PEER_TOPK)
    i1 = jnp.take_along_axis(half_i[..., 0, :], best_pos // PEER_TOPK, axis=-1)
    i2 = jnp.take_along_axis(half_i[..., 1, :], best_pos % PEER_TOPK, axis=-1)
    experts = i1 * PEER_N_KEYS + i2
    gates = jax.nn.softmax(best_s, axis=-1)
    nb = (B * S) // PEER_TOKEN_BLOCK
    hk = PEER_HEADS * PEER_TOPK
    xs = (h.reshape(nb, PEER_TOKEN_BLOCK, D),
          experts.reshape(nb, PEER_TOKEN_BLOCK, hk),
          gates.reshape(nb, PEER_TOKEN_BLOCK, hk))

    def block(args):
        x_b, e_b, g_b = args
        u = jnp.take(u_tab, e_b, axis=0)
        a = jnp.einsum('td,tkd->tk', x_b, u).astype(jnp.float32)
        w = (jax.nn.gelu(a, approximate=False) * g_b).astype(v_tab.dtype)
        return jnp.einsum('tk,tkd->td', w, jnp.take(v_tab, e_b, axis=0))

    y = lax.map(block, xs)
    return y.reshape(B, S, D)


def setup_inputs(seed: int = 0) -> dict:
    key = jax.random.key(seed)
    ks = jax.random.split(key, 32)
    f32 = jnp.float32

    def nrm(k, shape, scale):
        return jax.random.normal(k, shape, f32) * scale

    def gain(k, n):
        return 1.0 + 0.02 * jax.random.normal(k, (DEPTH, n), f32)

    return {
        'x': nrm(ks[0], (BATCH, SEQ, D_MODEL), 1.0),
        'mem': nrm(ks[1], (BATCH, MEM_LEN, D_MODEL), 1.0),
        'hgrn_lb_logits': nrm(ks[2], (DEPTH + 1, HG_WIDTH), 0.5),
        'mix_norm': gain(ks[3], D_MODEL),
        'w_in': nrm(ks[4], (DEPTH, D_MODEL, IN_COLS), D_MODEL ** -0.5),
        'diff_q_norm': gain(ks[5], DIFF_HEAD_DIM),
        'diff_k_norm': gain(ks[6], DIFF_HEAD_DIM),
        'diff_lambda_q1': nrm(ks[7], (DEPTH, DIFF_HEAD_DIM), 0.1),
        'diff_lambda_k1': nrm(ks[8], (DEPTH, DIFF_HEAD_DIM), 0.1),
        'diff_lambda_q2': nrm(ks[9], (DEPTH, DIFF_HEAD_DIM), 0.1),
        'diff_lambda_k2': nrm(ks[10], (DEPTH, DIFF_HEAD_DIM), 0.1),
        'diff_subln': gain(ks[11], DIFF_V_DIM),
        'hgrn_out_norm': gain(ks[12], HG_DV),
        'w_out': nrm(ks[13], (DEPTH, MIX_WIDTH, D_MODEL), MIX_WIDTH ** -0.5),
        'mem_norm': gain(ks[14], D_MODEL),
        'mem_kv_norm': gain(ks[15], D_MODEL),
        'w_mem_q': nrm(ks[16], (DEPTH, D_MODEL, MEM_WIDTH), D_MODEL ** -0.5),
        'w_mem_k': nrm(ks[17], (DEPTH, D_MODEL, MEM_WIDTH), D_MODEL ** -0.5),
        'w_mem_v': nrm(ks[18], (DEPTH, D_MODEL, MEM_WIDTH), D_MODEL ** -0.5),
        'mem_q_norm': gain(ks[19], MEM_HEAD_DIM),
        'mem_k_norm': gain(ks[20], MEM_HEAD_DIM),
        'w_mem_o': nrm(ks[21], (DEPTH, MEM_WIDTH, D_MODEL), MEM_WIDTH ** -0.5),
        'ffn_norm': gain(ks[22], D_MODEL),
        'peer_w_q': nrm(ks[23], (DEPTH, D_MODEL, PEER_HEADS * PEER_QDIM), D_MODEL ** -0.5),
        'peer_sub_keys': nrm(ks[24], (DEPTH, PEER_HEADS, 2, PEER_N_KEYS, PEER_HALF), PEER_HALF ** -0.5),
        'peer_u': nrm(ks[25], (DEPTH, PEER_N_EXPERTS, D_MODEL), D_MODEL ** -0.5),
        'peer_v': nrm(ks[26], (DEPTH, PEER_N_EXPERTS, D_MODEL), 0.5),
    }


def reference(x, mem, hgrn_lb_logits, mix_norm, w_in, diff_q_norm, diff_k_norm,
              diff_lambda_q1, diff_lambda_k1, diff_lambda_q2, diff_lambda_k2, diff_subln,
              hgrn_out_norm, w_out, mem_norm, mem_kv_norm, w_mem_q, w_mem_k, w_mem_v,
              mem_q_norm, mem_k_norm, w_mem_o, ffn_norm, peer_w_q, peer_sub_keys,
              peer_u, peer_v):
    B, S, _ = x.shape
    f32 = jnp.float32
    split_points = [int(c) for c in np.cumsum(IN_SPLITS)[:-1]]
    lb_all = jnp.cumsum(jax.nn.softmax(hgrn_lb_logits.astype(f32), axis=0), axis=0)

    for l in range(DEPTH):
        h = rms_norm(x, mix_norm[l])
        proj = h @ w_in[l]
        dq, dk, dv, gq, gf, gi, gg = jnp.split(proj, split_points, axis=-1)

        lambda_init = 0.8 - 0.6 * math.exp(-0.3 * l)
        lam = (jnp.exp(jnp.sum(diff_lambda_q1[l].astype(f32) * diff_lambda_k1[l].astype(f32)))
               - jnp.exp(jnp.sum(diff_lambda_q2[l].astype(f32) * diff_lambda_k2[l].astype(f32)))
               + lambda_init)
        dq = rms_norm(dq.reshape(B, S, DIFF_HEADS, 2, DIFF_HEAD_DIM), diff_q_norm[l])
        dk = rms_norm(dk.reshape(B, S, DIFF_HEADS, 2, DIFF_HEAD_DIM), diff_k_norm[l])
        dv = dv.reshape(B, S, DIFF_HEADS, DIFF_V_DIM).astype(f32)
        d_out = diff_attention(dq, dk, dv, lam)
        d_out = rms_norm(d_out, diff_subln[l]) * (1.0 - lambda_init)

        lb = lb_all[l].reshape(HG_HEADS, HG_DK)
        gf32 = gf.astype(f32).reshape(B, S, HG_HEADS, HG_DK)
        log_f = jnp.log(lb + (1.0 - lb) * jax.nn.sigmoid(gf32))
        k_in = (1.0 - lb) * jax.nn.sigmoid(-gf32)
        q_hg = jax.nn.silu(gq.astype(f32)).reshape(B, S, HG_HEADS, HG_DK)
        v_hg = gi.astype(f32).reshape(B, S, HG_HEADS, HG_DV)
        o_hg = hgrn2_chunkwise(q_hg, k_in, v_hg, log_f)
        o_hg = rms_norm(o_hg, hgrn_out_norm[l]) * jax.nn.silu(gg.astype(f32).reshape(B, S, HG_HEADS, HG_DV))

        mixed = jnp.concatenate([d_out.reshape(B, S, DIFF_WIDTH),
                                 o_hg.reshape(B, S, HG_V_WIDTH)], axis=-1).astype(x.dtype)
        x = x + (mixed @ w_out[l]).astype(x.dtype)

        mem_n = rms_norm(mem, mem_kv_norm[l])
        x = x + memory_cross_attention(rms_norm(x, mem_norm[l]), mem_n, w_mem_q[l], w_mem_k[l],
                                       w_mem_v[l], w_mem_o[l], mem_q_norm[l], mem_k_norm[l]).astype(x.dtype)

        x = x + peer_ffn(rms_norm(x, ffn_norm[l]), peer_w_q[l], peer_sub_keys[l],
                         peer_u[l], peer_v[l]).astype(x.dtype)
    return x
```

```cpp
#include <hip/hip_runtime.h>
#include <stdint.h>
#include <stdio.h>

#ifndef N_LAUNCHES
#define N_LAUNCHES 1
#endif
#ifndef MQ_MODE
#define MQ_MODE 2
#endif
#ifndef PQ_MODE
#define PQ_MODE 2
#endif
#ifndef WO_MODE
#define WO_MODE 2
#endif

#define LAS __attribute__((address_space(3)))
typedef unsigned short bf16_t;
typedef short bf16x8 __attribute__((ext_vector_type(8)));
typedef short s16x4 __attribute__((ext_vector_type(4)));
typedef float f32x2 __attribute__((ext_vector_type(2)));
typedef float f32x4 __attribute__((ext_vector_type(4)));
typedef float f32x16 __attribute__((ext_vector_type(16)));
typedef unsigned u32x2 __attribute__((ext_vector_type(2)));
typedef unsigned u32x4 __attribute__((ext_vector_type(4)));
typedef int i32x4_t __attribute__((ext_vector_type(4)));

constexpr int NB = 4, SEQ = 4096, DM = 4096, NTOK = NB * SEQ;
constexpr int IN_COLS = 14336, NSLAB = IN_COLS / 128;
constexpr size_t SLAB = (size_t)NTOK * 128;
constexpr int MEM_LEN = 256, NMEM = NB * MEM_LEN;
constexpr int NEXP = 16384;
constexpr float EPS = 1e-6f;
#ifndef TAB_BITS
#define TAB_BITS 4
#endif
constexpr float U_SCALE = TAB_BITS == 8 ? 512.f : 128.f, V_SCALE = TAB_BITS == 8 ? 16.f : 4.f;
constexpr int TAB_ROW = DM * TAB_BITS / 8;
constexpr float H_SCALE = 8.f, XG_SCALE = 4.f, W_SCALE = 512.f;
constexpr float MIX_I8 = 127.f / 8.f;
constexpr float H_I8 = 127.f / 6.f, XG_I8 = 127.f / 8.f, W_I8 = 127.f * 64.f / 5.5f;

constexpr int SL_DQ = 0, SL_DK = 16, SL_DV = 32, SL_GQ = 48, SL_GF = 64, SL_GI = 80, SL_GG = 96;

constexpr size_t WS_CTL    = 0;
constexpr size_t WS_ROWSS1 = 16384;
constexpr size_t WS_ROWSS2 = WS_ROWSS1 + 131072;
constexpr size_t CTL_ZERO_BYTES = WS_ROWSS2 + 131072;
constexpr size_t WS_WIN   = 1u << 20;
constexpr size_t WS_WIN8  = WS_WIN  + (size_t)8192 * DM * 2;
constexpr size_t WS_WIN8E = WS_WIN  + (size_t)6144 * DM * 2;
constexpr size_t WS_WIN8D = WS_WIN  + (size_t)12288 * DM * 2;
constexpr size_t WS_WIN8C = WS_WIN  + (size_t)2048 * DM * 2;
constexpr size_t WS_WIN8B = WS_WIN  + (size_t)10240 * DM * 2;
constexpr size_t WS_WOUT  = WS_WIN  + (size_t)IN_COLS * DM * 2;
constexpr size_t WS_WMQ   = WS_WOUT + (size_t)DM * DM * 2;
constexpr size_t WS_WMKV  = WS_WMQ  + (size_t)512 * DM * 2;
constexpr size_t WS_WMO   = WS_WMKV + (size_t)1024 * DM * 2;
constexpr size_t WS_WPQ   = WS_WMO  + (size_t)DM * 512 * 2;
constexpr size_t WS_KEYS  = WS_WPQ  + (size_t)2048 * DM * 2;
constexpr size_t WS_MEMN  = WS_KEYS + (size_t)8 * 2 * 128 * 128 * 2;
constexpr size_t WS_MEMKV = WS_MEMN + (size_t)NMEM * DM * 2;
constexpr size_t WS_A     = WS_MEMKV + (size_t)8 * NMEM * 128 * 2;
constexpr size_t WS_P     = WS_A + (size_t)NTOK * DM * 2;
constexpr size_t WS_HGO   = WS_P + (size_t)NSLAB * SLAB * 2;
constexpr size_t WS_QMEM  = WS_HGO + (size_t)NTOK * 2048 * 2;
constexpr size_t WS_OMEM  = WS_QMEM + (size_t)4 * SLAB * 2;
constexpr size_t WS_EXP   = WS_OMEM + (size_t)NTOK * 512 * 2;
constexpr size_t WS_GATE  = WS_EXP + (size_t)NTOK * 128 * 4;
constexpr size_t WS_END   = WS_GATE + (size_t)NTOK * 128 * 4;

constexpr int LDS_BYTES = 147456;
constexpr int KN_LDS = 133120;
constexpr int LDS_MISC = 131072;

__device__ __forceinline__ float bf2f(unsigned short b) { return __uint_as_float(((unsigned)b) << 16); }
typedef __bf16 bf16x2_t __attribute__((ext_vector_type(2)));
__device__ __forceinline__ void bf8_f32(const u32x4 r, f32x4& lo, f32x4& hi) {
    lo = (f32x4){__uint_as_float(r.x << 16), __uint_as_float(r.x & 0xffff0000u), __uint_as_float(r.y << 16), __uint_as_float(r.y & 0xffff0000u)};
    hi = (f32x4){__uint_as_float(r.z << 16), __uint_as_float(r.z & 0xffff0000u), __uint_as_float(r.w << 16), __uint_as_float(r.w & 0xffff0000u)}; }
__device__ __forceinline__ unsigned cvtpk(float lo, float hi) { const bf16x2_t r = __builtin_convertvector((f32x2){lo, hi}, bf16x2_t); return __builtin_bit_cast(unsigned, r); }
__device__ __forceinline__ unsigned short f2bf(float x) { return (unsigned short)(cvtpk(x, x) & 0xffffu); }
#define DPPF(x, ctrl) __int_as_float(__builtin_amdgcn_update_dpp(0, __float_as_int(x), (ctrl), 0xF, 0xF, true))
__device__ __forceinline__ float row16_allsum(float x) { x += DPPF(x, 0xB1); x += DPPF(x, 0x4E); x += DPPF(x, 0x141); x += DPPF(x, 0x140); return x; }
__device__ __forceinline__ float rdlane(float x, int l) { return __int_as_float(__builtin_amdgcn_readlane(__float_as_int(x), l)); }
__device__ __forceinline__ float wave_allsum(float x) { x = row16_allsum(x); return (rdlane(x, 0) + rdlane(x, 16)) + (rdlane(x, 32) + rdlane(x, 48)); }
__device__ __forceinline__ float half_allsum(float x) { x = row16_allsum(x); return x + __shfl_xor(x, 16); }
__device__ __forceinline__ float rowscale(const unsigned long long* rowss, int row) { return __builtin_amdgcn_rsqf((float)rowss[row] * (1.0f / 4294967296.0f) * (1.0f / DM) + EPS); }
__device__ __forceinline__ unsigned pk4_fp8(float a, float b, float c, float d) { int t = __builtin_amdgcn_cvt_pk_fp8_f32(a, b, 0, false); t = __builtin_amdgcn_cvt_pk_fp8_f32(c, d, t, true); return (unsigned)t; }
__device__ __forceinline__ unsigned pk4_i8(float a, float b, float c, float d) {
    const int ia = (int)__builtin_rintf(__builtin_amdgcn_fmed3f(a, -127.f, 127.f)), ib = (int)__builtin_rintf(__builtin_amdgcn_fmed3f(b, -127.f, 127.f));
    const int ic = (int)__builtin_rintf(__builtin_amdgcn_fmed3f(c, -127.f, 127.f)), id = (int)__builtin_rintf(__builtin_amdgcn_fmed3f(d, -127.f, 127.f));
    return (unsigned)(ia & 0xff) | ((unsigned)(ib & 0xff) << 8) | ((unsigned)(ic & 0xff) << 16) | ((unsigned)(id & 0xff) << 24);
}
template <int MODE> __device__ __forceinline__ unsigned pk4_q(float a, float b, float c, float d) { if constexpr (MODE == 2) return pk4_i8(a, b, c, d); else return pk4_fp8(a, b, c, d); }
__device__ __forceinline__ float sigmoidf_(float x) { return __builtin_amdgcn_rcpf(1.f + __builtin_amdgcn_exp2f(-1.4426950408889634f * x)); }

#define XB_TMO      128
#define XB_XCNT(j)  (256  + 64 * (j))
#define XB_XSUB(j)  (1280 + 64 * (j))
#define XB_XGEN(j)  (2304 + 64 * (j))
#define XB_TOP      3328
#define XB_TOPGEN   3392
#define XCD_BAR_WORDS 3456
#define XB_SPIN_CAP (1u << 20)
__device__ __forceinline__ unsigned xb_ld(unsigned* p)              { return __hip_atomic_load(p, __ATOMIC_RELAXED, __HIP_MEMORY_SCOPE_AGENT); }
__device__ __forceinline__ unsigned xb_add(unsigned* p, unsigned v) { return __hip_atomic_fetch_add(p, v, __ATOMIC_RELAXED, __HIP_MEMORY_SCOPE_AGENT); }
__device__ __forceinline__ unsigned xb_xcc_id() { return (unsigned)__builtin_amdgcn_s_getreg((3 << 11) | 20) & 0xFu; }
#define XB_SPIN(cond, bar) do { unsigned _sp = 0; while (cond) { __builtin_amdgcn_s_sleep(1); \
    if ((++_sp & 255u) == 0u) { if (xb_ld(&(bar)[XB_TMO])) break; if (_sp > XB_SPIN_CAP) { atomicAdd(&(bar)[XB_TMO], 1u); break; } } } } while (0)
struct XcdBarrier { unsigned* bar; unsigned x; volatile LAS unsigned* st; };
__device__ __forceinline__ XcdBarrier xcd_barrier_post(unsigned* bar, volatile LAS unsigned* st) {
    XcdBarrier b; b.bar = bar; b.x = xb_xcc_id(); b.st = st;
    if (threadIdx.x == 0) (void)xb_add(&bar[XB_XCNT(b.x)], 1u);
    return b;
}
__device__ __forceinline__ void xcd_barrier_complete(unsigned* bar, unsigned x, unsigned& nloc, unsigned& nx) {
    const unsigned G = gridDim.x * gridDim.y * gridDim.z;
    unsigned sum, cnt, mine, sp = 0u;
    for (;;) {
        sum = 0u; cnt = 0u; mine = 0u;
#pragma unroll
        for (unsigned j = 0; j < 16; ++j) { const unsigned c = xb_ld(&bar[XB_XCNT(j)]); sum += c; cnt += (c > 0u) ? 1u : 0u; mine = (j == x) ? c : mine; }
        if (sum == G) break;
        __builtin_amdgcn_s_sleep(1);
        if ((++sp & 255u) == 0u) { if (xb_ld(&bar[XB_TMO])) break; if (sp > XB_SPIN_CAP) { atomicAdd(&bar[XB_TMO], 1u); break; } }
    }
    nloc = mine > 0u ? mine : 1u; nx = cnt > 0u ? cnt : 1u;
}
__device__ __forceinline__ void xcd_barrier(const XcdBarrier& b) {
    asm volatile("s_waitcnt vmcnt(0)" ::: "memory");
    __syncthreads();
    if (threadIdx.x == 0) {
        unsigned* bar = b.bar;
        __builtin_amdgcn_s_waitcnt(0);
        unsigned nloc = b.st[0], nx = b.st[1];
        if (nloc == 0u) { xcd_barrier_complete(bar, b.x, nloc, nx); b.st[0] = nloc; b.st[1] = nx; }
        const unsigned old = xb_add(&bar[XB_XSUB(b.x)], 1u);
        const unsigned gen = old / nloc;
        if (old + 1u == (gen + 1u) * nloc) {
            __builtin_amdgcn_fence(__ATOMIC_RELEASE, "agent");
            asm volatile("s_waitcnt vmcnt(0)" ::: "memory");
            const unsigned og = xb_add(&bar[XB_TOP], 1u);
            const unsigned tg = og / nx;
            if (og + 1u == (tg + 1u) * nx) xb_add(&bar[XB_TOPGEN], 1u);
            else XB_SPIN(xb_ld(&bar[XB_TOPGEN]) == tg, bar);
            __builtin_amdgcn_fence(__ATOMIC_ACQUIRE, "agent");
            xb_add(&bar[XB_XGEN(b.x)], 1u);
            asm volatile("s_waitcnt vmcnt(0)" ::: "memory");
        } else {
            XB_SPIN(xb_ld(&bar[XB_XGEN(b.x)]) == gen, bar);
            __builtin_amdgcn_fence(__ATOMIC_ACQUIRE, "agent");
            asm volatile("s_waitcnt vmcnt(0)" ::: "memory");
        }
    }
    __syncthreads();
}

namespace pg8 {
constexpr int BM = 256, BK = 64, HALF = 128, HTB = HALF * BK * 2, STAGE_BYTES = 8 * HTB, NXCD = 8, WGM = 8;
__device__ __forceinline__ int lds_byte(int r, int c) { const int st = (r >> 4) * 2 + (c >> 5), rr = r & 15, cc = c & 31, ob = rr * 64 + cc * 2; return st * 1024 + (ob ^ (((ob >> 9) & 1) << 5)); }
__device__ __forceinline__ void stage_rc(int b, int& R, int& C) { const int st = b / 1024, sb = b % 1024, swz = sb ^ (((sb >> 9) & 1) << 5); R = (st >> 1) * 16 + swz / 64; C = (st & 1) * 32 + (swz % 64) / 2; }
__device__ __forceinline__ int perm32(int rho) { const int n = rho >> 4, i = rho & 15; return 8 * (i >> 2) + 4 * n + (i & 3); }
struct Unit { int pm, pn; };
struct Gemm { const void* A; const void* Bt; int M, N, K, lda, ldb; };
struct StaticOrder {
    int nM, nN, nwg, G, c;
    __device__ void init(int M, int N, int G_, int c_) { nM = M / BM; nN = N / BM; nwg = nM * nN; G = G_; c = c_; }
    __device__ bool next(int i, Unit& u) const {
        const long L = (long)i * G + c; if (L >= nwg) return false;
        int wgid = (int)L; { const int q = nwg / NXCD, r = nwg % NXCD, xcd = wgid % NXCD, off = wgid / NXCD; wgid = (xcd < r ? xcd * (q + 1) : r * (q + 1) + (xcd - r) * q) + off; }
        const int nig = WGM * nN, gid = wgid / nig, fm = gid * WGM, gsz = (nM - fm) < WGM ? (nM - fm) : WGM;
        u.pm = fm + ((wgid % nig) % gsz); u.pn = (wgid % nig) / gsz; return true;
    }
};
typedef int i32x8 __attribute__((ext_vector_type(8)));
__device__ __forceinline__ i32x8 cat8(bf16x8 a, bf16x8 b) { const u32x4 x = __builtin_bit_cast(u32x4, a), y = __builtin_bit_cast(u32x4, b); return (i32x8){(int)x[0], (int)x[1], (int)x[2], (int)x[3], (int)y[0], (int)y[1], (int)y[2], (int)y[3]}; }
typedef int i32x4v __attribute__((ext_vector_type(4)));
template <class Epi, int F8>
__device__ __forceinline__ void gemm_phase(LAS unsigned char* lds, const Gemm g, const StaticOrder& S, const Epi& E) {
    const int tid = threadIdx.x, wid = __builtin_amdgcn_readfirstlane(tid >> 6), lane = tid & 63, wr = wid >> 2, wc = wid & 3, fr = lane & 15, fq = lane >> 4;
    const int K = g.K, nt = K / (F8 != 0 ? 2 * BK : BK);
    unsigned voffA[2], voffB[2];
#pragma unroll
    for (int i = 0; i < 2; ++i) { int R, C; stage_rc(tid * 16 + i * 8192, R, C); const int Rb = (R & ~31) + perm32(R & 31);
        voffA[i] = (unsigned)(R * g.lda + C * 2); voffB[i] = (unsigned)(Rb * g.ldb + C * 2); }
    const size_t kstep = (size_t)(BK * 2);
    const size_t hstepA = (size_t)HALF * g.lda, hstepB = (size_t)HALF * g.ldb;
    const size_t tstepA = 2 * hstepA, tstepB = 2 * hstepB;
    const unsigned ldsw = (unsigned)wid * 1024u;
    const int aoff = lds_byte(wr * 64 + fr, fq * 8), boff = lds_byte(wc * 32 + fr, fq * 8);
#define PG8_SA(b, h) (((b) * 2 + (h)) * HTB)
#define PG8_SB(b, h) ((4 + (b) * 2 + (h)) * HTB)
#define PG8_STAGE(bufoff, gbase, voff) do { _Pragma("unroll") for (int _i = 0; _i < 2; ++_i) \
        __builtin_amdgcn_global_load_lds((const unsigned*)((const char*)(gbase) + (voff)[_i]), (LAS unsigned*)(lds + (bufoff) + ldsw + _i * 8192), 16, 0, 0); } while (0)
#define PG8_LDA(dst, b, h) do { _Pragma("unroll") for (int m = 0; m < 4; ++m) _Pragma("unroll") for (int k = 0; k < 2; ++k) dst[m][k] = *(const LAS bf16x8*)(lds + PG8_SA(b, h) + aoff + m * 2048 + k * 1024); } while (0)
#define PG8_LDB(dst, b, h) do { _Pragma("unroll") for (int n = 0; n < 2; ++n) _Pragma("unroll") for (int k = 0; k < 2; ++k) dst[n][k] = *(const LAS bf16x8*)(lds + PG8_SB(b, h) + boff + n * 2048 + k * 1024); } while (0)
#define PG8_MMA(ai, bj, At, Bt) do { __builtin_amdgcn_s_setprio(1); _Pragma("unroll") for (int m = 0; m < 4; ++m) _Pragma("unroll") for (int n = 0; n < 2; ++n) { \
        if constexpr (F8 == 1) { const i32x8 b8_ = cat8(Bt[n][0], Bt[n][1]), a8_ = cat8(At[m][0], At[m][1]); \
            asm volatile("v_mfma_scale_f32_16x16x128_f8f6f4 %0, %1, %2, %0, %3, %3 op_sel_hi:[0,0,0]" : "+v"(acc[ai][bj][m][n]) : "v"(b8_), "v"(a8_), "v"(sc127)); } \
        else if constexpr (F8 == 2) { _Pragma("unroll") for (int k = 0; k < 2; ++k) acc[ai][bj][m][n] = __builtin_bit_cast(f32x4, __builtin_amdgcn_mfma_i32_16x16x64_i8(__builtin_bit_cast(i32x4v, Bt[n][k]), __builtin_bit_cast(i32x4v, At[m][k]), __builtin_bit_cast(i32x4v, acc[ai][bj][m][n]), 0, 0, 0)); } \
        else { _Pragma("unroll") for (int k = 0; k < 2; ++k) acc[ai][bj][m][n] = __builtin_amdgcn_mfma_f32_16x16x32_bf16(Bt[n][k], At[m][k], acc[ai][bj][m][n], 0, 0, 0); } } __builtin_amdgcn_s_setprio(0); } while (0)
#define PG8_WAIT_V(n) asm volatile("s_waitcnt vmcnt(" #n ")" ::: "memory")
#define PG8_WAIT_L(n) asm volatile("s_waitcnt lgkmcnt(" #n ")" ::: "memory")
#define PG8_BAR __builtin_amdgcn_s_barrier()
#define PG8_SCHED __builtin_amdgcn_sched_barrier(0)
    Unit cur, nxt; int ui = 0;
    if (!S.next(0, cur)) return;
    int sc127 = 127; asm volatile("" : "+v"(sc127));
    f32x4 acc[2][2][4][2];
#pragma unroll
    for (int a = 0; a < 2; ++a)
#pragma unroll
        for (int b = 0; b < 2; ++b)
#pragma unroll
            for (int m = 0; m < 4; ++m)
#pragma unroll
                for (int n = 0; n < 2; ++n) acc[a][b][m][n] = (f32x4){0.f, 0.f, 0.f, 0.f};
    bf16x8 At[4][2], B0[2][2], B1[2][2];
    const char* cA = (const char*)g.A + (size_t)cur.pm * tstepA; const char* cB = (const char*)g.Bt + (size_t)cur.pn * tstepB;
    PG8_STAGE(PG8_SB(0, 0), cB, voffB); PG8_STAGE(PG8_SA(0, 0), cA, voffA); PG8_STAGE(PG8_SB(0, 1), cB + hstepB, voffB); PG8_STAGE(PG8_SA(0, 1), cA + hstepA, voffA);
    if (wr == 1) PG8_BAR;
    PG8_WAIT_V(4); PG8_BAR;
    PG8_STAGE(PG8_SB(1, 0), cB + kstep, voffB); PG8_STAGE(PG8_SA(1, 0), cA + kstep, voffA); PG8_STAGE(PG8_SB(1, 1), cB + hstepB + kstep, voffB);
    PG8_WAIT_V(6); PG8_BAR;
    for (;;) {
        const bool has_next = S.next(ui + 1, nxt);
        const char* nA = has_next ? (const char*)g.A + (size_t)nxt.pm * tstepA : cA; const char* nB = has_next ? (const char*)g.Bt + (size_t)nxt.pn * tstepB : cB;
        for (int t = 0; t < nt; t += 2) {
            const bool last = (t == nt - 2);
            const char* a1 = cA + (size_t)(t + 1) * kstep;
            const char* a2 = last ? nA : cA + (size_t)(t + 2) * kstep; const char* b2 = last ? nB : cB + (size_t)(t + 2) * kstep;
            const char* a3 = a2 + kstep; const char* b3 = b2 + kstep;
            PG8_LDB(B0, 0, 0); PG8_SCHED; PG8_LDA(At, 0, 0); PG8_STAGE(PG8_SA(1, 1), a1 + hstepA, voffA);
            PG8_WAIT_L(8); PG8_BAR; PG8_WAIT_L(0); PG8_MMA(0, 0, At, B0); PG8_BAR; PG8_SCHED;
            PG8_LDB(B1, 0, 1); PG8_STAGE(PG8_SB(0, 0), b2, voffB);
            PG8_BAR; PG8_WAIT_L(0); PG8_MMA(0, 1, At, B1); PG8_BAR;
            PG8_LDA(At, 0, 1); PG8_STAGE(PG8_SA(0, 0), a2, voffA);
            PG8_BAR; PG8_WAIT_L(0); PG8_MMA(1, 0, At, B0); PG8_BAR; PG8_SCHED;
            PG8_STAGE(PG8_SB(0, 1), b2 + hstepB, voffB);
            PG8_WAIT_V(6); PG8_BAR; PG8_MMA(1, 1, At, B1); PG8_BAR;
            PG8_LDB(B0, 1, 0); PG8_SCHED; PG8_LDA(At, 1, 0); PG8_STAGE(PG8_SA(0, 1), a2 + hstepA, voffA);
            PG8_WAIT_L(8); PG8_BAR; PG8_WAIT_L(0); PG8_MMA(0, 0, At, B0); PG8_BAR; PG8_SCHED;
            PG8_LDB(B1, 1, 1); PG8_STAGE(PG8_SB(1, 0), b3, voffB);
            PG8_BAR; PG8_WAIT_L(0); PG8_MMA(0, 1, At, B1); PG8_BAR;
            PG8_LDA(At, 1, 1); PG8_STAGE(PG8_SA(1, 0), a3, voffA);
            PG8_BAR; PG8_WAIT_L(0); PG8_MMA(1, 0, At, B0); PG8_BAR; PG8_SCHED;
            PG8_STAGE(PG8_SB(1, 1), b3 + hstepB, voffB);
            PG8_WAIT_V(6); PG8_BAR; PG8_MMA(1, 1, At, B1); PG8_BAR;
        }
        if constexpr (F8 == 2) {
#pragma unroll
            for (int a = 0; a < 2; ++a)
#pragma unroll
                for (int b = 0; b < 2; ++b)
#pragma unroll
                    for (int m = 0; m < 4; ++m)
#pragma unroll
                        for (int n = 0; n < 2; ++n) { const i32x4v iv = __builtin_bit_cast(i32x4v, acc[a][b][m][n]); acc[a][b][m][n] = (f32x4){(float)iv[0], (float)iv[1], (float)iv[2], (float)iv[3]}; }
        }
        if constexpr (F8 == 1) asm volatile("s_nop 15\n\ts_nop 7" ::: "memory");
        E(acc, cur, wr, wc, fr, fq);
        if (!has_next) break;
#pragma unroll
        for (int a = 0; a < 2; ++a)
#pragma unroll
            for (int b = 0; b < 2; ++b)
#pragma unroll
                for (int m = 0; m < 4; ++m)
#pragma unroll
                    for (int n = 0; n < 2; ++n) acc[a][b][m][n] = (f32x4){0.f, 0.f, 0.f, 0.f};
        cur = nxt; cA = nA; cB = nB; ++ui;
    }
    PG8_WAIT_V(0);
    if (wr == 0) PG8_BAR;
    PG8_BAR;
#undef PG8_SA
#undef PG8_SB
#undef PG8_STAGE
#undef PG8_LDA
#undef PG8_LDB
#undef PG8_MMA
#undef PG8_WAIT_V
#undef PG8_WAIT_L
#undef PG8_BAR
#undef PG8_SCHED
}

struct EpiBf16S {
    bf16_t* O; const unsigned long long* rowss; int slab; size_t slab_stride; int ldc; float descale; int sl_split, sl_d0, sl_d1;
    const float* kn_gain; int kn_lo, kn_hi; LAS float* kn_lds;
    __device__ __forceinline__ void operator()(const f32x4 (&acc)[2][2][4][2], const Unit& u, int wr, int wc, int fr, int fq) const {
        const int row0 = u.pm * BM + wr * 64 + fr;
        const bool kn = kn_gain != nullptr && u.pn * 2 >= kn_lo && u.pn * 2 < kn_hi;
        float rsn[2][4][2]; f32x4 kg0 = {1.f, 1.f, 1.f, 1.f}, kg1 = {1.f, 1.f, 1.f, 1.f};
        if (kn) {
            kg0 = *(const f32x4*)(kn_gain + wc * 32 + 8 * fq); kg1 = *(const f32x4*)(kn_gain + wc * 32 + 8 * fq + 4);
#pragma unroll
            for (int ai = 0; ai < 2; ++ai)
#pragma unroll
                for (int m = 0; m < 4; ++m)
#pragma unroll
                    for (int bj = 0; bj < 2; ++bj) {
                        const f32x4 v0 = acc[ai][bj][m][0], v1 = acc[ai][bj][m][1];
                        float ss = (v0[0] * v0[0] + v0[1] * v0[1]) + (v0[2] * v0[2] + v0[3] * v0[3]) + (v1[0] * v1[0] + v1[1] * v1[1]) + (v1[2] * v1[2] + v1[3] * v1[3]);
                        ss += __shfl_xor(ss, 16); ss += __shfl_xor(ss, 32);
                        if (fq == 0) kn_lds[((wr * 64 + fr + ai * HALF + m * 16) * 2 + bj) * 4 + wc] = ss;
                    }
            asm volatile("s_waitcnt lgkmcnt(0)\n\ts_barrier" ::: "memory");
#pragma unroll
            for (int ai = 0; ai < 2; ++ai)
#pragma unroll
                for (int m = 0; m < 4; ++m)
#pragma unroll
                    for (int bj = 0; bj < 2; ++bj) {
                        const f32x4 t = *(const LAS f32x4*)(kn_lds + ((wr * 64 + fr + ai * HALF + m * 16) * 2 + bj) * 4);
                        rsn[ai][m][bj] = __builtin_amdgcn_rsqf(((t[0] + t[1]) + (t[2] + t[3])) * (descale * descale) * (1.0f / 128.0f) + EPS);
                    }
        }
        float rsc[2][4];
#pragma unroll
        for (int ai = 0; ai < 2; ++ai)
#pragma unroll
            for (int m = 0; m < 4; ++m) rsc[ai][m] = rowss ? descale * rowscale(rowss, row0 + ai * HALF + m * 16) : descale;
        __builtin_amdgcn_sched_barrier(0);
#pragma unroll
        for (int ai = 0; ai < 2; ++ai)
#pragma unroll
            for (int m = 0; m < 4; ++m) {
                const int row = row0 + ai * HALF + m * 16;
                const float sc = rsc[ai][m];
#pragma unroll
                for (int bj = 0; bj < 2; ++bj) {
                    f32x4 v0 = acc[ai][bj][m][0] * sc, v1 = acc[ai][bj][m][1] * sc;
                    if (kn) { v0 = v0 * rsn[ai][m][bj] * kg0; v1 = v1 * rsn[ai][m][bj] * kg1; }
                    u32x4 w; w.x = cvtpk(v0[0], v0[1]); w.y = cvtpk(v0[2], v0[3]); w.z = cvtpk(v1[0], v1[1]); w.w = cvtpk(v1[2], v1[3]);
                    const int sl_ = u.pn * 2 + bj;
                    bf16_t* p = slab ? O + (size_t)(sl_ + (sl_ < sl_split ? sl_d0 : sl_d1)) * slab_stride + (size_t)row * 128 + wc * 32 + 8 * fq
                                     : O + (size_t)row * ldc + u.pn * BM + bj * HALF + wc * 32 + 8 * fq;
                    *(u32x4*)p = w; }
            }
    }
};
template <int G8, bool BASE_BF16> struct EpiResid {
    const void* base; bf16_t* out; void* outg; const float* gain; unsigned long long* rowss; float descale;
    __device__ __forceinline__ void operator()(const f32x4 (&acc)[2][2][4][2], const Unit& u, int wr, int wc, int fr, int fq) const {
        const int row0 = u.pm * BM + wr * 64 + fr, col0 = u.pn * BM + wc * 32 + 8 * fq;
        f32x4 gv[2][2];
        if constexpr (G8 > 0) {
#pragma unroll
            for (int bj = 0; bj < 2; ++bj)
#pragma unroll
                for (int n = 0; n < 2; ++n) gv[bj][n] = *(const f32x4*)(gain + col0 + bj * HALF + 4 * n);
        }
        f32x4 val[2][2][4][2]; float ssr[2][4];
#pragma unroll
        for (int ai = 0; ai < 2; ++ai)
#pragma unroll
            for (int m = 0; m < 4; ++m) {
                const int row = row0 + ai * HALF + m * 16; float ss = 0.f;
#pragma unroll
                for (int bj = 0; bj < 2; ++bj) {
                    const size_t off = (size_t)row * DM + col0 + bj * HALF;
                    f32x4 b0, b1;
                    if constexpr (BASE_BF16) bf8_f32(*(const u32x4*)((const bf16_t*)base + off), b0, b1);
                    else { b0 = *(const f32x4*)((const float*)base + off); b1 = *(const f32x4*)((const float*)base + off + 4); }
                    const f32x4 v0 = acc[ai][bj][m][0] * descale + b0, v1 = acc[ai][bj][m][1] * descale + b1;
                    val[ai][bj][m][0] = v0; val[ai][bj][m][1] = v1;
                    ss += (v0[0] * v0[0] + v0[1] * v0[1]) + (v0[2] * v0[2] + v0[3] * v0[3]) + (v1[0] * v1[0] + v1[1] * v1[1]) + (v1[2] * v1[2] + v1[3] * v1[3]); }
                ss += __shfl_xor(ss, 16); ss += __shfl_xor(ss, 32);
                ssr[ai][m] = ss;
                if (m == 3) __builtin_amdgcn_sched_barrier(0);
            }
        __builtin_amdgcn_sched_barrier(0);
#pragma unroll
        for (int ai = 0; ai < 2; ++ai)
#pragma unroll
            for (int m = 0; m < 4; ++m) {
                const int row = row0 + ai * HALF + m * 16;
#pragma unroll
                for (int bj = 0; bj < 2; ++bj) {
                    const size_t off = (size_t)row * DM + col0 + bj * HALF;
                    const f32x4 v0 = val[ai][bj][m][0], v1 = val[ai][bj][m][1];
                    { u32x4 w; w.x = cvtpk(v0[0], v0[1]); w.y = cvtpk(v0[2], v0[3]); w.z = cvtpk(v1[0], v1[1]); w.w = cvtpk(v1[2], v1[3]); *(u32x4*)(out + off) = w; }
                    if constexpr (G8 > 0) { constexpr float GS = G8 == 2 ? XG_I8 : XG_SCALE; const f32x4 g0 = v0 * gv[bj][0] * GS, g1 = v1 * gv[bj][1] * GS;
                        u32x2 w; w.x = pk4_q<G8>(g0[0], g0[1], g0[2], g0[3]); w.y = pk4_q<G8>(g1[0], g1[1], g1[2], g1[3]);
                        *(u32x2*)((unsigned char*)outg + off) = w; } }
                if (fq == 0) atomicAdd(rowss + row, (unsigned long long)(ssr[ai][m] * 4294967296.0f));
            }
    }
};
}

namespace att {
constexpr int D = 128, NW = 8, QBLK = 32, KVBLK = 64, QB = NW * QBLK;
constexpr int SHM_V = KVBLK * D * 2, SHM_K = KVBLK * D * 2;
constexpr int ATT_LDS = 2 * SHM_V + 2 * SHM_K + NW * 64 * 4;
constexpr float SCALE = 0.08838834764831845f, THR = 8.f;
#define KSWZ(row, colB) ((row) * 256 + ((colB) ^ (((row) & 7) << 4)))
#define SBAR() __builtin_amdgcn_sched_barrier(0)
__device__ __forceinline__ int v_st(int k, int c) { const int kk = (k & ~0xC) | ((k & 4) << 1) | ((k & 8) >> 1); return ((kk >> 3) * 4 + (c >> 5)) * 512 + ((kk & 7) * 32 + (c & 31)) * 2; }
__device__ __forceinline__ int v_rd_base(int lane) { return ((lane & 3) << 3) | (((lane >> 2) & 3) << 6) | (((lane >> 4) & 1) << 5) | (((lane >> 5) & 1) << 8); }
constexpr int v_rd_off(int d0, int ks, int half) { return d0 * 512 + ks * 4096 + half * 2048; }
__device__ __forceinline__ int crow(int r, int hi) { return (r & 3) + 8 * (r >> 2) + 4 * hi; }
__device__ __forceinline__ bf16x8 load8(const bf16_t* p) { return *reinterpret_cast<const bf16x8*>(p); }
__device__ __forceinline__ void mask_tile(f32x16& p0, f32x16& p1, int dq) {
    const float NEG = -__builtin_inff();
#pragma unroll
    for (int r = 0; r < 16; ++r) {
        const int c = (r & 3) + 8 * (r >> 2);
        if (dq - c < 0) p0[r] = NEG;
        if (dq - c - 32 < 0) p1[r] = NEG;
    }
}
__device__ __forceinline__ void partialSM(f32x16& p0, f32x16& p1, float& m_reg, float& mn, float& alpha, bool masked) {
    float pmax = p0[0]; for (int r = 1; r < 16; ++r) pmax = fmaxf(pmax, p0[r]); for (int r = 0; r < 16; ++r) pmax = fmaxf(pmax, p1[r]);
    { auto rr = __builtin_amdgcn_permlane32_swap(__float_as_uint(pmax), __float_as_uint(pmax), false, false);
      pmax = fmaxf(__uint_as_float(rr[0]), __uint_as_float(rr[1])); }
    if (masked) pmax = -__builtin_inff();
    constexpr float C2 = 1.4426950408889634f * SCALE;
    if (__builtin_expect(__all((pmax - m_reg) * SCALE <= THR), 1)) { mn = m_reg; alpha = 1.f; }
    else { mn = fmaxf(m_reg, pmax); alpha = __builtin_amdgcn_exp2f((m_reg - mn) * C2); m_reg = mn; }
    const float mnL = masked ? -__builtin_inff() : -mn * C2;
    for (int r = 0; r < 16; ++r) p0[r] = fmaf(p0[r], C2, mnL); for (int r = 0; r < 16; ++r) p1[r] = fmaf(p1[r], C2, mnL);
    for (int r = 0; r < 16; ++r) p0[r] = __builtin_amdgcn_exp2f(p0[r]);
}
__device__ __forceinline__ void finishSM(f32x16& p0, f32x16& p1, float alpha, float& l_reg, bf16x8& pa0, bf16x8& pa1, bf16x8& pa2, bf16x8& pa3) {
    for (int r = 0; r < 16; ++r) p1[r] = __builtin_amdgcn_exp2f(p1[r]);
    float ps = 0; for (int r = 0; r < 16; ++r) ps += p0[r]; for (int r = 0; r < 16; ++r) ps += p1[r];
    { auto rr = __builtin_amdgcn_permlane32_swap(__float_as_uint(ps), __float_as_uint(ps), false, false);
      ps = __uint_as_float(rr[0]) + __uint_as_float(rr[1]); }
    l_reg = l_reg * alpha + ps;
#define PK4(P, B_, OUT) do { unsigned a0 = cvtpk(P[B_+0], P[B_+1]), a1 = cvtpk(P[B_+2], P[B_+3]);                          \
        unsigned b0 = cvtpk(P[B_+4], P[B_+5]), b1 = cvtpk(P[B_+6], P[B_+7]);                                             \
        auto r0 = __builtin_amdgcn_permlane32_swap(a0, b0, false, false); auto r1 = __builtin_amdgcn_permlane32_swap(a1, b1, false, false); \
        u32x4 w = {r0[0], r1[0], r0[1], r1[1]}; OUT = *reinterpret_cast<bf16x8*>(&w); } while (0)
    PK4(p0, 0, pa0); PK4(p0, 8, pa1); PK4(p1, 0, pa2); PK4(p1, 8, pa3);
#undef PK4
}
template <int KB>
__device__ __forceinline__ void qkt(f32x16& p0, f32x16& p1, const char* K_lds, int r32, int hi, const bf16x8* qr) {
    p0 = f32x16{}; p1 = f32x16{};
    const char* kb[4];
#pragma unroll
    for (int dd = 0; dd < 4; ++dd) kb[dd] = K_lds + KB * SHM_K + KSWZ(r32, (dd * 16 + hi * 8) * 2);
#pragma unroll
    for (int d0 = 0; d0 < 8; ++d0) { const char* a = kb[d0 & 3] + (d0 >> 2) * 128;
        bf16x8 b0 = *reinterpret_cast<const bf16x8*>(a);
        bf16x8 b1 = *reinterpret_cast<const bf16x8*>(a + 32 * 256);
        p0 = __builtin_amdgcn_mfma_f32_32x32x16_bf16(b0, qr[d0], p0, 0, 0, 0);
        p1 = __builtin_amdgcn_mfma_f32_32x32x16_bf16(b1, qr[d0], p1, 0, 0, 0); }
}
template <int VB>
__device__ __forceinline__ void pv_tile(f32x16* o, int vb0, bf16x8 pa0, bf16x8 pa1, bf16x8 pa2, bf16x8 pa3) {
#define TRRD(dst, off) asm volatile("ds_read_b64_tr_b16 %0, %1 offset:%2" : "=&v"(dst) : "v"(vb0), "i"(off) : "memory")
#define PV_D0(d0) do { s16x4 l0, l1, l2, l3, h0, h1, h2, h3; constexpr int b_ = VB * SHM_V + v_rd_off(d0, 0, 0); \
        TRRD(l0, b_); TRRD(h0, b_ + 2048); TRRD(l1, b_ + 4096); TRRD(h1, b_ + 6144); TRRD(l2, b_ + 8192); TRRD(h2, b_ + 10240); TRRD(l3, b_ + 12288); TRRD(h3, b_ + 14336); \
        asm volatile("s_waitcnt lgkmcnt(0)" ::: "memory"); SBAR();   \
        o[d0] = __builtin_amdgcn_mfma_f32_32x32x16_bf16(pa0, (bf16x8){l0[0], l0[1], l0[2], l0[3], h0[0], h0[1], h0[2], h0[3]}, o[d0], 0, 0, 0);   \
        o[d0] = __builtin_amdgcn_mfma_f32_32x32x16_bf16(pa1, (bf16x8){l1[0], l1[1], l1[2], l1[3], h1[0], h1[1], h1[2], h1[3]}, o[d0], 0, 0, 0);   \
        o[d0] = __builtin_amdgcn_mfma_f32_32x32x16_bf16(pa2, (bf16x8){l2[0], l2[1], l2[2], l2[3], h2[0], h2[1], h2[2], h2[3]}, o[d0], 0, 0, 0);   \
        o[d0] = __builtin_amdgcn_mfma_f32_32x32x16_bf16(pa3, (bf16x8){l3[0], l3[1], l3[2], l3[3], h3[0], h3[1], h3[2], h3[3]}, o[d0], 0, 0, 0); } while (0)
    PV_D0(0); PV_D0(1); PV_D0(2); PV_D0(3);
#undef PV_D0
#undef TRRD
}
struct BlockRef { const bf16_t* Q; const bf16_t* K; const bf16_t* V; bf16_t* O; int P0; };
struct Seam { bf16x8 qr[8]; bf16x8 st_v0, st_v1, st_k0, st_k1; };
#define ROW(p, k0, rr) ((p) + (size_t)((k0) + (rr)) * D + sc)
#define VMW() asm volatile("s_waitcnt vmcnt(0)" ::: "memory")
#define VMWN(n) asm volatile("s_waitcnt vmcnt(%0)" :: "i"(n) : "memory")
#define SLOAD_H(Kp, Vp, k0) do { S.st_v0 = load8(ROW(Vp, k0, sr)); S.st_v1 = load8(ROW(Vp, k0, 32 + sr));              \
                         S.st_k0 = load8(ROW(Kp, k0, sr)); S.st_k1 = load8(ROW(Kp, k0, 32 + sr)); } while (0)
#define SWRITE_HK(bf) do { *(bf16x8*)(K_lds + (bf) * SHM_K + kws) = S.st_k0; *(bf16x8*)(K_lds + (bf) * SHM_K + kws + 32 * 256) = S.st_k1; } while (0)
#define SWRITE_HV(bf) do { *(bf16x8*)(V_lds + (bf) * SHM_V + vst0) = S.st_v0; *(bf16x8*)(V_lds + (bf) * SHM_V + vst1) = S.st_v1; } while (0)
#define SWRITE_H(bf) do { SWRITE_HV(bf); SWRITE_HK(bf); } while (0)
__device__ __forceinline__ void attn_prime(const BlockRef& cur, char* lds, Seam& S) {
    const int tid = threadIdx.x, wid = __builtin_amdgcn_readfirstlane(tid >> 6), lane = tid & 63, r32 = lane & 31, hi = lane >> 5;
    const int sr = tid >> 4, sc = (tid & 15) * 8, kws = KSWZ(sr, sc * 2); char* K_lds = lds + 2 * SHM_V;
    for (int d0 = 0; d0 < 8; ++d0) S.qr[d0] = load8(cur.Q + (size_t)(wid * QBLK + r32) * D + d0 * 16 + hi * 8);
    SLOAD_H(cur.K, cur.V, 0); VMW(); SWRITE_HK(0);
    __syncthreads();
}
__device__ __forceinline__ void qnorm(bf16x8 (&qr)[8], const float* gain, int hi) {
    float ss = 0.f;
#pragma unroll
    for (int d0 = 0; d0 < 8; ++d0)
#pragma unroll
        for (int j = 0; j < 8; ++j) { const float v = bf2f((unsigned short)qr[d0][j]); ss += v * v; }
    { auto rr = __builtin_amdgcn_permlane32_swap(__float_as_uint(ss), __float_as_uint(ss), false, false); ss = __uint_as_float(rr[0]) + __uint_as_float(rr[1]); }
    const float rs = __builtin_amdgcn_rsqf(ss * (1.0f / 128.0f) + EPS);
#pragma unroll
    for (int d0 = 0; d0 < 8; ++d0) {
        const f32x4 g0 = *(const f32x4*)(gain + d0 * 16 + hi * 8), g1 = *(const f32x4*)(gain + d0 * 16 + hi * 8 + 4);
        float v[8];
#pragma unroll
        for (int j = 0; j < 8; ++j) v[j] = bf2f((unsigned short)qr[d0][j]) * rs;
        u32x4 w; w.x = cvtpk(v[0] * g0[0], v[1] * g0[1]); w.y = cvtpk(v[2] * g0[2], v[3] * g0[3]); w.z = cvtpk(v[4] * g1[0], v[5] * g1[1]); w.w = cvtpk(v[6] * g1[2], v[7] * g1[3]);
        qr[d0] = *reinterpret_cast<bf16x8*>(&w);
    }
}
template <bool CAUSAL>
__device__ __forceinline__ void attn_block(const BlockRef& cur, const BlockRef& nxt, int skv, int ldo, const float* qgain, char* lds, Seam& S) {
    const int tid = threadIdx.x, wid = __builtin_amdgcn_readfirstlane(tid >> 6), lane = tid & 63, r32 = lane & 31, hi = lane >> 5;
    int j_hi = skv / KVBLK; if (CAUSAL) { const int jh = (cur.P0 + QB - 1) / KVBLK + 1; if (jh < j_hi) j_hi = jh; }
    const int NT = j_hi;
    const int qlo = (cur.P0 + wid * QBLK) | 63;
    char* V_lds = lds; char* K_lds = lds + 2 * SHM_V;
    float* ws = (float*)(lds + 2 * SHM_V + 2 * SHM_K) + wid * 64; float* li_l = ws, * al_l = ws + 32;
    float m_reg = -1e30f, l_reg = 0; f32x16 o[4] = {};
    const int sr = tid >> 4, sc = (tid & 15) * 8, vst0 = v_st(sr, sc), vst1 = v_st(32 + sr, sc), kws = KSWZ(sr, sc * 2);
    const int vb0 = (int)(uintptr_t)V_lds + v_rd_base(lane);
    const bf16_t* Kh = cur.K; const bf16_t* Vh = cur.V;
    qnorm(S.qr, qgain, hi);
    if (wid >= 4) __builtin_amdgcn_s_setprio(1);
#define RESC(a) do { if (__any((a) < 1.f)) { if (hi == 0) al_l[r32] = (a); asm volatile("s_waitcnt lgkmcnt(0)" ::: "memory");              \
                     for (int d_ = 0; d_ < 4; ++d_) for (int r = 0; r < 16; ++r) o[d_][r] *= al_l[crow(r, hi)]; } } while (0)
#define KBASE(t) ((t) * KVBLK)
#define MASKT(t) (CAUSAL && KBASE(t) > qlo)
    constexpr int NQL = 8;
#define SEAM_K0() do { VMWN(NQL); SWRITE_HK(0); SBAR(); } while (0)
    f32x16 pA0, pA1, pB0, pB1; float mnA, mnB, alA, alB; bf16x8 pa0, pa1, pa2, pa3;
    SWRITE_HV(0); SBAR();
    if (NT > 1) { SLOAD_H(Kh, Vh, KBASE(1)); }
    SBAR(); qkt<0>(pA0, pA1, K_lds, r32, hi, S.qr);
    partialSM(pA0, pA1, m_reg, mnA, alA, false);
    if (NT > 1) { VMW(); SWRITE_H(1); }
    __syncthreads();
#define HALF_STEP(PX0, PX1, mnX, alX, PY0, PY1, alY, t, KB, VB, SB) do {                                                      \
        SBAR(); if ((t) + 1 < NT) { SLOAD_H(Kh, Vh, KBASE((t) + 1)); SBAR(); }                                       \
        qkt<KB>(PX0, PX1, K_lds, r32, hi, S.qr);                                             \
        finishSM(PY0, PY1, alY, l_reg, pa0, pa1, pa2, pa3); SBAR();                                                           \
        pv_tile<VB>(o, vb0, pa0, pa1, pa2, pa3); partialSM(PX0, PX1, m_reg, mnX, alX, MASKT(t));                                        \
        __syncthreads();                                                                                                      \
        if ((t) + 1 < NT) { VMW(); SWRITE_H(SB); }                                                                          \
        RESC(alX); __syncthreads(); } while (0)
    for (int t = 1; t + 1 < NT; t += 2) {
        HALF_STEP(pB0, pB1, mnB, alB, pA0, pA1, alA, t, 1, 0, 0);
        HALF_STEP(pA0, pA1, mnA, alA, pB0, pB1, alB, t + 1, 0, 1, 1);
    }
    const bool even = (NT & 1) == 0;
    if (even) { SBAR(); qkt<1>(pB0, pB1, K_lds, r32, hi, S.qr); SBAR(); }
    SLOAD_H(nxt.K, nxt.V, 0); SBAR();
#pragma unroll
    for (int d0 = 0; d0 < 8; ++d0) S.qr[d0] = load8(nxt.Q + (size_t)(wid * QBLK + r32) * D + d0 * 16 + hi * 8);
    SBAR();
    finishSM(pA0, pA1, alA, l_reg, pa0, pa1, pa2, pa3); SBAR();
    pv_tile<0>(o, vb0, pa0, pa1, pa2, pa3);
    if (even) { partialSM(pB0, pB1, m_reg, mnB, alB, MASKT(NT - 1)); __syncthreads(); RESC(alB);
        finishSM(pB0, pB1, alB, l_reg, pa0, pa1, pa2, pa3); SBAR(); pv_tile<1>(o, vb0, pa0, pa1, pa2, pa3); }
    SBAR(); SEAM_K0();
    if (hi == 0) li_l[r32] = l_reg; asm volatile("s_waitcnt lgkmcnt(0)" ::: "memory");
    float rli[16];
#pragma unroll
    for (int r = 0; r < 16; ++r) rli[r] = __builtin_amdgcn_rcpf(li_l[crow(r, hi)]);
    bf16_t* Ow = cur.O + (size_t)(wid * QBLK) * ldo;
#pragma unroll
    for (int r = 0; r < 16; ++r) { const int orow = crow(r, hi);
#pragma unroll
        for (int d0 = 0; d0 < 4; ++d0) { const float v = o[d0][r] * rli[r];
            const float vn = __shfl_xor(v, 1);
            if ((r32 & 1) == 0) *(unsigned*)(Ow + (size_t)orow * ldo + d0 * 32 + r32) = cvtpk(v, vn); } }
    __builtin_amdgcn_s_setprio(0);
    __syncthreads();
#undef RESC
#undef KBASE
#undef MASKT
#undef SEAM_K0
#undef HALF_STEP
}
#undef ROW
#undef VMW
#undef VMWN
#undef SLOAD_H
#undef SWRITE_HK
#undef SWRITE_HV
#undef SWRITE_H
}

struct Params { const float* in[27]; float* out; unsigned char* ws; int ph_lo, ph_hi; };
enum { I_X = 0, I_MEM, I_LB, I_MIXN, I_WIN, I_DQN, I_DKN, I_LQ1, I_LK1, I_LQ2, I_LK2, I_SUBLN, I_HGN, I_WOUT, I_MEMN, I_MEMKVN, I_WMQ, I_WMK, I_WMV, I_MQN, I_MKN, I_WMO, I_FFNN, I_PWQ, I_PKEYS, I_PU, I_PV };
constexpr int NPHASE = 12;

template <int F8, bool RG = false>
__device__ __forceinline__ void transpose_cvt(const float* src, int R, int C, int lsrc, void* dstv, int ldd, int row_off, float scale, LAS unsigned char* lds, int wg, int nwg, const float* rgain = nullptr) {
    const int tid = threadIdx.x, ntc = C / 64, ntiles = (R / 64) * ntc;
    const int r = tid >> 3, c8 = (tid & 7) * 8;
    if (wg >= ntiles) return;
    const int nw = (ntiles - wg + nwg - 1) / nwg;
    f32x4 aA, bA, aB, bB; float gA = 1.f, gB = 1.f;
#define TC_TILE(j) (wg + ((j) < nw ? (j) : nw - 1) * nwg)
#define TC_LOAD(a_, b_, g_, j) do { const int t_ = TC_TILE(j); const float* p_ = src + (size_t)((t_ / ntc) * 64 + r) * lsrc + (t_ % ntc) * 64 + c8; a_ = *(const f32x4*)p_; b_ = *(const f32x4*)(p_ + 4); \
        if constexpr (RG) g_ = rgain[(t_ / ntc) * 64 + r]; } while (0)
#define TC_STEP(a_, b_, g_, j, BUF) do { const int ti_ = TC_TILE(j), tr = ti_ / ntc, tc = ti_ % ntc; LAS unsigned char* tl = lds + (BUF) * 9216; \
        asm volatile("" : "+v"(a_), "+v"(b_));     \
        { const float sc_ = RG ? scale * g_ : scale; const f32x4 as = a_ * sc_, bs = b_ * sc_; \
          if constexpr (F8 != 0) { \
              const unsigned w0 = pk4_q<F8>(as[0], as[1], as[2], as[3]), w1 = pk4_q<F8>(bs[0], bs[1], bs[2], bs[3]); \
              _Pragma("unroll") for (int q_ = 0; q_ < 4; ++q_) { tl[(c8 + q_) * 72 + r] = (unsigned char)(w0 >> (8 * q_)); tl[(c8 + 4 + q_) * 72 + r] = (unsigned char)(w1 >> (8 * q_)); } \
          } else { \
              LAS bf16_t* tile = (LAS bf16_t*)tl;                            \
              tile[(c8 + 0) * 72 + r] = f2bf(as[0]); tile[(c8 + 1) * 72 + r] = f2bf(as[1]); tile[(c8 + 2) * 72 + r] = f2bf(as[2]); tile[(c8 + 3) * 72 + r] = f2bf(as[3]); \
              tile[(c8 + 4) * 72 + r] = f2bf(bs[0]); tile[(c8 + 5) * 72 + r] = f2bf(bs[1]); tile[(c8 + 6) * 72 + r] = f2bf(bs[2]); tile[(c8 + 7) * 72 + r] = f2bf(bs[3]); \
          } } \
        TC_LOAD(a_, b_, g_, (j) + 2); \
        asm volatile("s_waitcnt lgkmcnt(0)\n\ts_barrier" ::: "memory"); \
        { const int c = tid >> 3, r8 = (tid & 7) * 8; \
          if constexpr (F8 != 0) { const u32x2 w = *(const LAS u32x2*)(tl + c * 72 + r8); \
              *(u32x2*)((unsigned char*)dstv + (size_t)(row_off + tc * 64 + c) * ldd + tr * 64 + r8) = w; } \
          else { const u32x4 w = *(const LAS u32x4*)((LAS bf16_t*)tl + c * 72 + r8); \
              *(u32x4*)((bf16_t*)dstv + (size_t)(row_off + tc * 64 + c) * ldd + tr * 64 + r8) = w; } } } while (0)
#define TC_PLACEHOLDER(j) do { const int ti_ = TC_TILE(j), tr = ti_ / ntc, tc = ti_ % ntc; const int c = tid >> 3, r8 = (tid & 7) * 8; \
        if constexpr (F8 != 0) *(u32x2*)((unsigned char*)dstv + (size_t)(row_off + tc * 64 + c) * ldd + tr * 64 + r8) = (u32x2){0u, 0u}; \
        else *(u32x4*)((bf16_t*)dstv + (size_t)(row_off + tc * 64 + c) * ldd + tr * 64 + r8) = (u32x4){0u, 0u, 0u, 0u}; } while (0)
    TC_LOAD(aA, bA, gA, 0); __builtin_amdgcn_sched_barrier(0); TC_PLACEHOLDER(0); __builtin_amdgcn_sched_barrier(0);
    TC_LOAD(aB, bB, gB, 1); __builtin_amdgcn_sched_barrier(0); TC_PLACEHOLDER(1); __builtin_amdgcn_sched_barrier(0);
    for (int j = 0; j < nw; j += 2) {
        TC_STEP(aA, bA, gA, j, 0);
        TC_STEP(aB, bB, gB, j + 1, 1);
    }
#undef TC_TILE
#undef TC_LOAD
#undef TC_STEP
#undef TC_PLACEHOLDER
    __syncthreads();
}
__device__ __forceinline__ void rmsnorm_rows_i8(const float* x, const float* gain, unsigned char* out, int nrows, int wave_gid, int nwaves, LAS unsigned char* lds) {
    const int tid = threadIdx.x, lane = tid & 63, wid = tid >> 6;
    for (int i = tid; i < DM / 4; i += 512) *(LAS f32x4*)(lds + i * 16) = *(const f32x4*)(gain + i * 4);
    __syncthreads();
    LAS unsigned char* strip = lds + 16384 + wid * 4096;
    int row = wave_gid;
    if (row < nrows) {
        f32x4 v[16], vn[16];
#pragma unroll
        for (int i = 0; i < 16; ++i) v[i] = *(const f32x4*)(x + (size_t)row * DM + lane * 4 + i * 256);
        for (; row < nrows; row += nwaves) {
            const int nrow = row + nwaves < nrows ? row + nwaves : row;
#pragma unroll
            for (int i = 0; i < 16; ++i) vn[i] = *(const f32x4*)(x + (size_t)nrow * DM + lane * 4 + i * 256);
            float ss = 0.f;
#pragma unroll
            for (int i = 0; i < 16; ++i) ss += (v[i][0] * v[i][0] + v[i][1] * v[i][1]) + (v[i][2] * v[i][2] + v[i][3] * v[i][3]);
            ss = wave_allsum(ss);
            const float rs = __builtin_amdgcn_rsqf(ss * (1.0f / DM) + EPS) * H_I8;
#pragma unroll
            for (int i = 0; i < 16; ++i) { const f32x4 g = *(const LAS f32x4*)(lds + (i * 256 + lane * 4) * 4);
                *(LAS unsigned*)(strip + i * 256 + lane * 4) = pk4_i8(v[i][0] * rs * g[0], v[i][1] * rs * g[1], v[i][2] * rs * g[2], v[i][3] * rs * g[3]); }
#pragma unroll
            for (int j = 0; j < 4; ++j) { const u32x4 w = *(const LAS u32x4*)(strip + j * 1024 + lane * 16);
                *(u32x4*)(out + (size_t)row * DM + j * 1024 + lane * 16) = w; }
#pragma unroll
            for (int i = 0; i < 16; ++i) v[i] = vn[i];
        }
    }
    __syncthreads();
}
template <int MODE>
__device__ __forceinline__ void rmsnorm_rows(const float* x, const float* gain, void* outv, unsigned char* out8, int nrows, int wave_gid, int nwaves) {
    const int lane = threadIdx.x & 63;
    int row = wave_gid; if (row >= nrows) return;
    f32x4 v[16], vn[16];
#pragma unroll
    for (int i = 0; i < 16; ++i) v[i] = *(const f32x4*)(x + (size_t)row * DM + lane * 4 + i * 256);
    for (; row < nrows; row += nwaves) {
        const int nrow = row + nwaves;
        if (nrow < nrows) {
#pragma unroll
            for (int i = 0; i < 16; ++i) vn[i] = *(const f32x4*)(x + (size_t)nrow * DM + lane * 4 + i * 256); }
        float ss = 0.f;
#pragma unroll
        for (int i = 0; i < 16; ++i) ss += (v[i][0] * v[i][0] + v[i][1] * v[i][1]) + (v[i][2] * v[i][2] + v[i][3] * v[i][3]);
        ss = wave_allsum(ss);
        const float rs = __builtin_amdgcn_rsqf(ss * (1.0f / DM) + EPS);
#pragma unroll
        for (int i = 0; i < 16; ++i) { const f32x4 g = *(const f32x4*)(gain + i * 256 + lane * 4);
            const float a = v[i][0] * rs * g[0], b = v[i][1] * rs * g[1], c = v[i][2] * rs * g[2], d = v[i][3] * rs * g[3];
            if constexpr (MODE == 3) *(unsigned*)((unsigned char*)outv + (size_t)row * DM + lane * 4 + i * 256) = pk4_i8(a * H_I8, b * H_I8, c * H_I8, d * H_I8);
            else if constexpr (MODE != 0) *(unsigned*)((MODE == 1 ? (unsigned char*)outv : out8) + (size_t)row * DM + lane * 4 + i * 256) = pk4_fp8(a * H_SCALE, b * H_SCALE, c * H_SCALE, d * H_SCALE);
            if constexpr (MODE != 1 && MODE != 3) { u32x2 w; w.x = cvtpk(a, b); w.y = cvtpk(c, d); *(u32x2*)((bf16_t*)outv + (size_t)row * DM + lane * 4 + i * 256) = w; } }
#pragma unroll
        for (int i = 0; i < 16; ++i) v[i] = vn[i];
    }
}

__device__ __forceinline__ void knorm_rows(bf16_t* base, size_t nrows, const float* gain, int wave_gid, int nwaves) {
    const int lane = threadIdx.x & 63, sub = lane >> 4, l16 = lane & 15;
    const f32x4 g0 = *(const f32x4*)(gain + l16 * 8), g1 = *(const f32x4*)(gain + l16 * 8 + 4);
    for (size_t r16 = (size_t)wave_gid * 16; r16 < nrows; r16 += (size_t)nwaves * 16) {
        bf16x8 raw[4];
#pragma unroll
        for (int u = 0; u < 4; ++u) raw[u] = *(const bf16x8*)(base + (r16 + 4 * u + sub) * 128 + l16 * 8);
#pragma unroll
        for (int u = 0; u < 4; ++u) {
            float v[8]; float ss = 0.f;
#pragma unroll
            for (int j = 0; j < 8; ++j) { v[j] = bf2f((unsigned short)raw[u][j]); ss += v[j] * v[j]; }
            ss = row16_allsum(ss);
            const float rs = __builtin_amdgcn_rsqf(ss * (1.0f / 128.0f) + EPS);
            u32x4 w; w.x = cvtpk(v[0] * rs * g0[0], v[1] * rs * g0[1]); w.y = cvtpk(v[2] * rs * g0[2], v[3] * rs * g0[3]);
            w.z = cvtpk(v[4] * rs * g1[0], v[5] * rs * g1[1]); w.w = cvtpk(v[6] * rs * g1[2], v[7] * rs * g1[3]);
            *(u32x4*)(base + (r16 + 4 * u + sub) * 128 + l16 * 8) = w;
        }
    }
}

constexpr int HR_QT = 0, HR_KET = 17408, HR_PM = 35840, HR_DEC = 45056;
constexpr int RF_QT = 0, RF_PM = 16384, RF_KET = 24576, RF_DEC = 40960, RF_VT = 41472, HR_BYTES = 59904;
constexpr int HP_QH = 46080, HP_KH = 63488, HP_VTF = 80896, HP_TOT = 99328;
constexpr size_t WS_HREC = WS_QMEM;
constexpr size_t WS_V4 = WS_HREC + (size_t)4096 * HR_BYTES + (1u << 20);
constexpr size_t WS_END2 = WS_V4 + (size_t)NEXP * DM / 2;
__device__ __forceinline__ void hgrn_prepass(const Params& p, LAS unsigned char* lds, int wg, int nwg) {
    const int tid = threadIdx.x, wid = __builtin_amdgcn_readfirstlane(tid >> 6), lane = tid & 63, l16 = lane & 15, q4 = lane >> 4;
    const bf16_t* P = (const bf16_t*)(p.ws + WS_P);
    const int k = tid & 127, tq = tid >> 7;
    LAS bf16_t* QT = (LAS bf16_t*)(lds + HR_QT); LAS bf16_t* KET = (LAS bf16_t*)(lds + HR_KET); LAS bf16_t* PM = (LAS bf16_t*)(lds + HR_PM); LAS float* DEC = (LAS float*)(lds + HR_DEC);
    LAS bf16_t* QH = (LAS bf16_t*)(lds + HP_QH); LAS bf16_t* KH = (LAS bf16_t*)(lds + HP_KH); LAS bf16_t* VTF = (LAS bf16_t*)(lds + HP_VTF); LAS float* TOT = (LAS float*)(lds + HP_TOT);
#define HP_BAR() asm volatile("s_waitcnt lgkmcnt(0)\n\ts_barrier" ::: "memory")
    unsigned short rq[16], rf[16]; bf16x8 rv0 = {}, rv1 = {}; float pl0 = 0.f, pl1 = 0.f;
    const int pvs = tid >> 3, pc16 = (tid & 7) * 16;
#define HP_PREFETCH(task_) do { const int t_ = (task_) < 4096 ? (task_) : 4095; const int b_ = t_ >> 10, hh_ = (t_ >> 6) & 15, c_ = t_ & 63; const size_t r0_ = (size_t)b_ * SEQ + (size_t)c_ * 64; \
        const bf16_t* gq_ = P + (size_t)(SL_GQ + hh_) * SLAB + r0_ * 128; const bf16_t* gf_ = P + (size_t)(SL_GF + hh_) * SLAB + r0_ * 128; const bf16_t* gi_ = P + (size_t)(SL_GI + hh_) * SLAB + r0_ * 128; \
        _Pragma("unroll") for (int i = 0; i < 16; ++i) { rq[i] = gq_[(tq * 16 + i) * 128 + k]; rf[i] = gf_[(tq * 16 + i) * 128 + k]; } \
        rv0 = *(const bf16x8*)(gi_ + pvs * 128 + pc16); rv1 = *(const bf16x8*)(gi_ + pvs * 128 + pc16 + 8); \
        pl0 = p.in[I_LB][hh_ * 128 + k]; pl1 = p.in[I_LB][2048 + hh_ * 128 + k]; } while (0)
#define HP_COPYOUT(rec_) do { _Pragma("unroll") for (int i = 0; i < 8; ++i) { int pc = tid + 512 * i; if (i == 7) pc = pc < 3744 ? pc : 3743; \
            const int f_ = (pc >> 6), fl16 = pc & 15, fq4 = (pc >> 4) & 3; int la_; \
            if (i < 2) la_ = HR_QT + ((16 * (f_ >> 2) + fl16) * 136 + 32 * (f_ & 3) + 8 * fq4) * 2; \
            else if (i == 2) la_ = HR_PM + ((16 * ((f_ - 16) >> 1) + fl16) * 72 + 32 * ((f_ - 16) & 1) + 8 * fq4) * 2; \
            else if (i < 5) la_ = HR_KET + ((16 * ((f_ - 24) >> 1) + fl16) * 72 + 32 * ((f_ - 24) & 1) + 8 * fq4) * 2; \
            else la_ = (i == 5 && pc < 2592) ? HR_DEC + (pc - 2560) * 16 : HP_VTF + (pc - 2592) * 16; \
            const u32x4 w = *(const LAS u32x4*)(lds + la_); \
            *(u32x4*)((rec_) + (size_t)pc * 16) = w; } } while (0)
    if (wg >= 4096) return;
    HP_PREFETCH(wg);
    unsigned char* rec_prev = p.ws + WS_HREC + (size_t)wg * HR_BYTES;
    for (int task = wg; task < 4096; task += nwg) {
        HP_COPYOUT(rec_prev);
        HP_BAR();
        rec_prev = p.ws + WS_HREC + (size_t)task * HR_BYTES;
        const float lb = 1.f / (1.f + __expf(pl1 - pl0));
        const float omlb = 1.f - lb;
        float lf[16], kin[16], qv[16];
#pragma unroll
        for (int i = 0; i < 16; ++i) {
            const float g = bf2f(rf[i]), sg = sigmoidf_(g);
            lf[i] = __builtin_amdgcn_logf(lb + omlb * sg);
            kin[i] = omlb * (1.f - sg);
            const float x = bf2f(rq[i]); qv[i] = x * sigmoidf_(x);
        }
        { const bf16x8 v0 = rv0, v1 = rv1;
#pragma unroll
          for (int j = 0; j < 8; ++j) { VTF[(pc16 + j) * 72 + pvs] = (bf16_t)v0[j]; VTF[(pc16 + 8 + j) * 72 + pvs] = (bf16_t)v1[j]; } }
        HP_PREFETCH(task + nwg);
#pragma unroll
        for (int i = 1; i < 16; ++i) lf[i] += lf[i - 1];
        TOT[tq * 128 + k] = lf[15];
        HP_BAR();
        const float t0 = TOT[k], t1 = TOT[128 + k], t2 = TOT[256 + k], t3 = TOT[384 + k];
        const float bmid = t0 + t1, blast = (t0 + t1) + (t2 + t3);
        const float off = tq == 0 ? 0.f : (tq == 1 ? t0 : (tq == 2 ? t0 + t1 : t0 + t1 + t2));
        unsigned ke[8];
#pragma unroll
        for (int i = 0; i < 16; ++i) {
            const float bb = off + lf[i];
            const float e_b = __builtin_amdgcn_exp2f(bb), e_rel = __builtin_amdgcn_exp2f(fminf(bb - bmid, 115.f)), e_inv = __builtin_amdgcn_exp2f(fminf(bmid - bb, 115.f)), e_end = __builtin_amdgcn_exp2f(blast - bb);
            const int t = tq * 16 + i;
            QT[t * 136 + k] = f2bf(qv[i] * e_b);
            QH[t * 136 + k] = f2bf(qv[i] * e_rel);
            KH[t * 136 + k] = f2bf(kin[i] * e_inv);
            const float kev = kin[i] * e_end;
            if (i & 1) ke[i >> 1] = (ke[i >> 1] & 0xffffu) | ((unsigned)f2bf(kev) << 16); else ke[i >> 1] = f2bf(kev);
        }
        *(LAS u32x4*)(KET + k * 72 + tq * 16) = (u32x4){ke[0], ke[1], ke[2], ke[3]};
        *(LAS u32x4*)(KET + k * 72 + tq * 16 + 8) = (u32x4){ke[4], ke[5], ke[6], ke[7]};
        if (tq == 0) DEC[k] = __builtin_amdgcn_exp2f(blast);
        HP_BAR();
        {
            const int tr = wid >> 1;
#pragma unroll
            for (int u = 0; u < 2; ++u) {
                const int tc = (wid & 1) + 2 * u;
                f32x4 a4 = {0.f, 0.f, 0.f, 0.f};
                if (tc <= tr) {
#pragma unroll
                    for (int ks = 0; ks < 4; ++ks) {
                        const bf16x8 A = *(const LAS bf16x8*)(QH + (16 * tr + l16) * 136 + 32 * ks + 8 * q4);
                        const bf16x8 B = *(const LAS bf16x8*)(KH + (16 * tc + l16) * 136 + 32 * ks + 8 * q4);
                        a4 = __builtin_amdgcn_mfma_f32_16x16x32_bf16(A, B, a4, 0, 0, 0);
                    }
                }
#pragma unroll
                for (int j = 0; j < 4; ++j) {
                    const int tl = 4 * q4 + j; float v = a4[j];
                    if (tc > tr || (tc == tr && l16 > tl)) v = 0.f;
                    PM[(16 * tr + tl) * 72 + 16 * tc + l16] = f2bf(v);
                }
            }
        }
        HP_BAR();
    }
    HP_COPYOUT(rec_prev);
    HP_BAR();
#undef HP_COPYOUT
#undef HP_BAR
#undef HP_PREFETCH
}
constexpr int HS_VB = 5120, HS_ST0 = 2 * HS_VB, HS_ST1 = HS_ST0 + 8704, HS_OB = HS_ST1 + 8704, HS_END = HS_OB + 2 * 5120;
struct HsFrag { bf16x8 pm[2], qt[4], ke[2]; };
__device__ __forceinline__ void hgrn_unit(const Params& p, int unit, LAS unsigned char* lds) {
    const int tid = threadIdx.x, wid = __builtin_amdgcn_readfirstlane(tid >> 6), lane = tid & 63, l16 = lane & 15, q4 = lane >> 4;
    const int b = unit >> 6, hh = (unit >> 2) & 15, vq = unit & 3;
    const unsigned char* rec0 = p.ws + WS_HREC + (size_t)((b * 16 + hh) * 64) * HR_BYTES;
    bf16_t* og = (bf16_t*)(p.ws + WS_HGO) + (size_t)b * SEQ * 2048 + hh * 128 + vq * 32;
    const int tr = wid >> 1, tn = wid & 1;
    const int vpc = tid < 320 ? tid : 319;
    const size_t voff = vpc < 288 ? (size_t)RF_VT + vq * 4608 + (size_t)vpc * 16 : (size_t)RF_DEC + (size_t)(vpc - 288) * 16;
    const size_t foff_pm = (size_t)RF_PM + (size_t)((tr * 2) * 64 + lane) * 16, foff_qt = (size_t)RF_QT + (size_t)((tr * 4) * 64 + lane) * 16, foff_ke = (size_t)RF_KET + (size_t)((wid * 2) * 64 + lane) * 16;
#define HS_REC(c) (rec0 + (size_t)((c) < 64 ? (c) : 63) * HR_BYTES)
#define HS_LOADF(F, c) do { const unsigned char* r_ = HS_REC(c); \
        _Pragma("unroll") for (int ks = 0; ks < 2; ++ks) F.pm[ks] = *(const bf16x8*)(r_ + foff_pm + ks * 1024); \
        _Pragma("unroll") for (int ks = 0; ks < 4; ++ks) F.qt[ks] = *(const bf16x8*)(r_ + foff_qt + ks * 1024); \
        _Pragma("unroll") for (int ks = 0; ks < 2; ++ks) F.ke[ks] = *(const bf16x8*)(r_ + foff_ke + ks * 1024); } while (0)
#define HS_LOADV(v, c) do { v = *(const u32x4*)(HS_REC(c) + voff); } while (0)
#define HS_WRITEV(v, VB) do { if (tid < 320) *(LAS u32x4*)(lds + (VB) * HS_VB + tid * 16) = v; } while (0)
#define HS_BAR() asm volatile("s_waitcnt lgkmcnt(0)\n\ts_barrier" ::: "memory")
    for (int i = tid; i < 8704 / 4; i += 512) ((LAS unsigned*)(lds + HS_ST0))[i] = 0u;
    f32x4 Sacc[2] = {(f32x4){0.f, 0.f, 0.f, 0.f}, (f32x4){0.f, 0.f, 0.f, 0.f}};
#define HS_STEP(F, c, VB) do { \
        const LAS bf16_t* VT = (const LAS bf16_t*)(lds + (VB) * HS_VB); const LAS float* DEC = (const LAS float*)(lds + (VB) * HS_VB + 4608); \
        const LAS bf16_t* STc = (const LAS bf16_t*)(lds + ((VB) ? HS_ST1 : HS_ST0)); \
        LAS bf16_t* STn = (LAS bf16_t*)(lds + ((VB) ? HS_ST0 : HS_ST1)); \
        f32x4 oa = {0.f, 0.f, 0.f, 0.f}; \
        _Pragma("unroll") for (int ks = 0; ks < 2; ++ks) { \
            const bf16x8 B = *(const LAS bf16x8*)(VT + (16 * tn + l16) * 72 + 32 * ks + 8 * q4); \
            oa = __builtin_amdgcn_mfma_f32_16x16x32_bf16(F.pm[ks], B, oa, 0, 0, 0); } \
        _Pragma("unroll") for (int ks = 0; ks < 4; ++ks) { \
            const bf16x8 B = *(const LAS bf16x8*)(STc + (16 * tn + l16) * 136 + 32 * ks + 8 * q4); \
            oa = __builtin_amdgcn_mfma_f32_16x16x32_bf16(F.qt[ks], B, oa, 0, 0, 0); } \
        { LAS bf16_t* ob_ = (LAS bf16_t*)(lds + HS_OB + (VB) * 5120); \
          _Pragma("unroll") for (int j = 0; j < 4; ++j) ob_[(16 * tr + 4 * q4 + j) * 40 + 16 * tn + l16] = f2bf(oa[j]); } \
        const f32x4 dc = *(const LAS f32x4*)(DEC + 16 * wid + 4 * q4); \
        _Pragma("unroll") for (int t2 = 0; t2 < 2; ++t2) { \
            f32x4 sv = Sacc[t2] * dc; \
            _Pragma("unroll") for (int ks = 0; ks < 2; ++ks) { \
                const bf16x8 B = *(const LAS bf16x8*)(VT + (16 * t2 + l16) * 72 + 32 * ks + 8 * q4); \
                sv = __builtin_amdgcn_mfma_f32_16x16x32_bf16(F.ke[ks], B, sv, 0, 0, 0); } \
            Sacc[t2] = sv; \
            u32x2 w; w.x = cvtpk(sv[0], sv[1]); w.y = cvtpk(sv[2], sv[3]); \
            *(LAS u32x2*)(STn + (16 * t2 + l16) * 136 + 16 * wid + 4 * q4) = w; } } while (0)
#define HS_OUT(cc, VB) do { const u32x2 w_ = *(const LAS u32x2*)(lds + HS_OB + (VB) * 5120 + (tid >> 3) * 80 + (tid & 7) * 8); \
        *(u32x2*)(og + ((size_t)(cc) * 64 + (tid >> 3)) * 2048 + (tid & 7) * 4) = w_; } while (0)
    HsFrag FA, FB; u32x4 vA, vB;
    HS_LOADF(FA, 0); HS_LOADV(vA, 0); HS_LOADV(vB, 1); HS_LOADF(FB, 1);
    HS_WRITEV(vA, 0);
    HS_BAR();
    for (int c = 0; c < 64; c += 2) {
        HS_LOADV(vA, c + 2);
        HS_OUT(c == 0 ? 0 : c - 1, 1);
        HS_STEP(FA, c, 0);
        HS_WRITEV(vB, 1);
        HS_LOADF(FA, c + 2);
        HS_BAR();
        HS_LOADV(vB, c + 3);
        HS_OUT(c, 0);
        HS_STEP(FB, c + 1, 1);
        HS_WRITEV(vA, 0);
        HS_LOADF(FB, c + 3);
        HS_BAR();
    }
    HS_OUT(63, 1);
#undef HS_OUT
#undef HS_REC
#undef HS_LOADF
#undef HS_LOADV
#undef HS_WRITEV
#undef HS_STEP
#undef HS_BAR
}

__device__ __forceinline__ att::BlockRef diff_ref(const Params& p, int L, int pass) {
    const int ph = L >> 3, x = L & 7, qb = pass ? 15 - x : x;
    const int b = ph >> 5, h = (ph >> 2) & 7, m = (ph >> 1) & 1, e = ph & 1;
    bf16_t* P = (bf16_t*)(p.ws + WS_P);
    att::BlockRef r;
    r.Q = P + (size_t)(SL_DQ + h * 2 + m) * SLAB + ((size_t)b * SEQ + qb * 256) * 128;
    r.K = P + (size_t)(SL_DK + h * 2 + m) * SLAB + (size_t)b * SEQ * 128;
    r.V = P + (size_t)(SL_DV + h * 2 + e) * SLAB + (size_t)b * SEQ * 128;
    r.O = (bf16_t*)(p.ws + WS_A) + (size_t)((h * 2 + m) * 2 + e) * SLAB + ((size_t)b * SEQ + qb * 256) * 128;
    r.P0 = qb * 256;
    return r;
}
__device__ __forceinline__ int diff_item(int wg, int G, int r) {
    if (G != 256) return wg + r * G;
    const int j = wg >> 3, bh = r * 8 + (wg & 7);
    return (bh * 4 + (j >> 3)) * 8 + (j & 7);
}
__device__ __forceinline__ att::BlockRef diff_ref2(const Params& p, int ph, int qb) {
    return diff_ref(p, ph * 8 + (qb < 8 ? qb : 15 - qb), qb < 8 ? 0 : 1);
}
constexpr int AQ_WORD = 3600, AQ_SLOT = 69632;
__device__ __forceinline__ int diff_claim(const Params& p, LAS unsigned char* ldsl) {
    if (threadIdx.x == 0) {
        const unsigned i = __hip_atomic_fetch_add((unsigned*)(p.ws + WS_CTL) + AQ_WORD + 16 * (blockIdx.x & 7), 1u, __ATOMIC_RELAXED, __HIP_MEMORY_SCOPE_AGENT);
        *(LAS int*)(ldsl + AQ_SLOT) = i < 64u ? (int)i : -1;
    }
    asm volatile("s_waitcnt lgkmcnt(0)\n\ts_barrier" ::: "memory");
    const int r = *(const LAS int*)(ldsl + AQ_SLOT);
    return __builtin_amdgcn_readfirstlane(r);
}
__device__ __forceinline__ void diff_attn_phase(const Params& p, char* lds, LAS unsigned char* ldsl) {
    const int total = 1024, G = gridDim.x, wg = blockIdx.x;
    const int nr = (total - wg + G - 1) / G;
    if (nr <= 0) return;
    const bool dyn = (G == 256);
    const int nrs = dyn ? 3 : nr;
    int r = 0, pass = 0;
    int L = diff_item(wg, G, 0);
    att::BlockRef cur = diff_ref(p, L, 0);
    att::Seam S;
    att::attn_prime(cur, lds, S);
    int dk = -2;
    for (;;) {
        att::BlockRef nxt = cur; bool last;
        if (dk == -2) {
            const bool more_pass = pass == 0, more_item = r + 1 < nrs;
            if (more_pass || more_item) {
                int passn = pass + 1, rn = r, Ln = L;
                if (!more_pass) { passn = 0; rn = r + 1; Ln = diff_item(wg, G, rn); }
                nxt = diff_ref(p, Ln, passn); pass = passn; L = Ln; r = rn; last = false;
            } else if (dyn) {
                dk = diff_claim(p, ldsl);
                if (dk >= 0) { nxt = diff_ref2(p, (24 + (wg & 7)) * 4 + (dk & 3), 15 - (dk >> 2)); last = false; } else last = true;
            } else last = true;
        } else {
            dk = diff_claim(p, ldsl);
            if (dk >= 0) { nxt = diff_ref2(p, (24 + (wg & 7)) * 4 + (dk & 3), 15 - (dk >> 2)); last = false; } else last = true;
        }
        att::attn_block<true>(cur, nxt, SEQ, 128, p.in[I_DQN], lds, S);
        if (last) break;
        cur = nxt;
    }
}

__device__ __forceinline__ void mixfinal_phase(const Params& p, int wave_gid, int nwaves) {
    const int lane = threadIdx.x & 63, half = lane >> 5, d4 = (lane & 31) * 4;
    float lam;
    { const float a = p.in[I_LQ1][lane] * p.in[I_LK1][lane] + p.in[I_LQ1][lane + 64] * p.in[I_LK1][lane + 64];
      const float c = p.in[I_LQ2][lane] * p.in[I_LK2][lane] + p.in[I_LQ2][lane + 64] * p.in[I_LK2][lane + 64];
      lam = __expf(wave_allsum(a)) - __expf(wave_allsum(c)) + 0.2f; }
    const bf16_t* AO = (const bf16_t*)(p.ws + WS_A);
    const bf16_t* HGO = (const bf16_t*)(p.ws + WS_HGO);
    const bf16_t* P = (const bf16_t*)(p.ws + WS_P);
    bf16_t* mixed = (bf16_t*)(p.ws + WS_P);
    const f32x4 gsub = *(const f32x4*)(p.in[I_SUBLN] + half * 128 + d4), ghg = *(const f32x4*)(p.in[I_HGN] + d4);
    for (int tok = wave_gid; tok < NTOK; tok += nwaves) {
        u32x2 a0[8], a1[8], ho[8], hg[8];
#pragma unroll
        for (int h = 0; h < 8; ++h) {
            a0[h] = *(const u32x2*)(AO + (size_t)((h * 2 + 0) * 2 + half) * SLAB + (size_t)tok * 128 + d4);
            a1[h] = *(const u32x2*)(AO + (size_t)((h * 2 + 1) * 2 + half) * SLAB + (size_t)tok * 128 + d4);
            const int hh = 2 * h + half;
            ho[h] = *(const u32x2*)(HGO + (size_t)tok * 2048 + hh * 128 + d4);
            hg[h] = *(const u32x2*)(P + (size_t)(SL_GG + hh) * SLAB + (size_t)tok * 128 + d4);
        }
#pragma unroll
        for (int h = 0; h < 8; ++h) {
            const int e = half;
            const u32x2 r0 = a0[h], r1 = a1[h];
            float d[4];
            d[0] = __uint_as_float(r0.x << 16) - lam * __uint_as_float(r1.x << 16); d[1] = __uint_as_float(r0.x & 0xffff0000u) - lam * __uint_as_float(r1.x & 0xffff0000u);
            d[2] = __uint_as_float(r0.y << 16) - lam * __uint_as_float(r1.y << 16); d[3] = __uint_as_float(r0.y & 0xffff0000u) - lam * __uint_as_float(r1.y & 0xffff0000u);
            float ss = (d[0] * d[0] + d[1] * d[1]) + (d[2] * d[2] + d[3] * d[3]);
            ss = wave_allsum(ss);
            const float rs = __builtin_amdgcn_rsqf(ss * (1.0f / 256.0f) + EPS) * 0.8f;
            const f32x4 g = gsub;
            if (WO_MODE == 2) *(unsigned*)((unsigned char*)mixed + (size_t)tok * DM + h * 256 + e * 128 + d4) = pk4_i8(d[0] * rs * g[0] * MIX_I8, d[1] * rs * g[1] * MIX_I8, d[2] * rs * g[2] * MIX_I8, d[3] * rs * g[3] * MIX_I8);
            else { u32x2 w; w.x = cvtpk(d[0] * rs * g[0], d[1] * rs * g[1]); w.y = cvtpk(d[2] * rs * g[2], d[3] * rs * g[3]);
            *(u32x2*)(mixed + (size_t)tok * DM + h * 256 + e * 128 + d4) = w; }
        }
#pragma unroll
        for (int h = 0; h < 8; ++h) {
            const int hh = 2 * h + half;
            const u32x2 r0 = ho[h], rg = hg[h];
            float o[4], gg[4];
            o[0] = __uint_as_float(r0.x << 16); o[1] = __uint_as_float(r0.x & 0xffff0000u); o[2] = __uint_as_float(r0.y << 16); o[3] = __uint_as_float(r0.y & 0xffff0000u);
            gg[0] = __uint_as_float(rg.x << 16); gg[1] = __uint_as_float(rg.x & 0xffff0000u); gg[2] = __uint_as_float(rg.y << 16); gg[3] = __uint_as_float(rg.y & 0xffff0000u);
            float ss = (o[0] * o[0] + o[1] * o[1]) + (o[2] * o[2] + o[3] * o[3]);
            ss = half_allsum(ss);
            const float rs = __builtin_amdgcn_rsqf(ss * (1.0f / 128.0f) + EPS);
            const f32x4 g = ghg;
            float r[4];
#pragma unroll
            for (int i = 0; i < 4; ++i) r[i] = o[i] * rs * g[i] * (gg[i] * sigmoidf_(gg[i]));
            if (WO_MODE == 2) *(unsigned*)((unsigned char*)mixed + (size_t)tok * DM + 2048 + hh * 128 + d4) = pk4_i8(r[0] * MIX_I8, r[1] * MIX_I8, r[2] * MIX_I8, r[3] * MIX_I8);
            else { u32x2 w; w.x = cvtpk(r[0], r[1]); w.y = cvtpk(r[2], r[3]);
            *(u32x2*)(mixed + (size_t)tok * DM + 2048 + hh * 128 + d4) = w; }
        }
    }
}

__device__ __forceinline__ unsigned pk8_fp4(const f32x4 a, const f32x4 b) {
    unsigned w = 0u;
    w = __builtin_amdgcn_cvt_scalef32_pk_fp4_f32(w, a[0], a[1], 1.0f, 0); w = __builtin_amdgcn_cvt_scalef32_pk_fp4_f32(w, a[2], a[3], 1.0f, 1);
    w = __builtin_amdgcn_cvt_scalef32_pk_fp4_f32(w, b[0], b[1], 1.0f, 2); w = __builtin_amdgcn_cvt_scalef32_pk_fp4_f32(w, b[2], b[3], 1.0f, 3);
    return w;
}
__device__ __forceinline__ void cvt_fp8_table(const float* src, unsigned char* dst, float scale, int gtid, int nthreads) {
    const size_t n16 = (size_t)NEXP * DM / 16;
#if TAB_BITS == 8
    for (size_t i = gtid; i < n16; i += nthreads) {
        const float* s = src + i * 16;
        const f32x4 a = *(const f32x4*)s * scale, b = *(const f32x4*)(s + 4) * scale, c = *(const f32x4*)(s + 8) * scale, d = *(const f32x4*)(s + 12) * scale;
        u32x4 w; w.x = pk4_fp8(a[0], a[1], a[2], a[3]); w.y = pk4_fp8(b[0], b[1], b[2], b[3]); w.z = pk4_fp8(c[0], c[1], c[2], c[3]); w.w = pk4_fp8(d[0], d[1], d[2], d[3]);
        *(u32x4*)(dst + i * 16) = w;
    }
#else
    for (size_t i = gtid; i < n16; i += (size_t)nthreads * 4) {
        f32x4 v[4][4];
#pragma unroll
        for (int u = 0; u < 4; ++u) { const size_t iu = i + (size_t)u * nthreads; if (iu < n16) { const float* s = src + iu * 16;
#pragma unroll
            for (int q = 0; q < 4; ++q) v[u][q] = *(const f32x4*)(s + 4 * q); } }
#pragma unroll
        for (int u = 0; u < 4; ++u) { const size_t iu = i + (size_t)u * nthreads; if (iu < n16)
            *(u32x2*)(dst + iu * 8) = (u32x2){pk8_fp4(v[u][0] * scale, v[u][1] * scale), pk8_fp4(v[u][2] * scale, v[u][3] * scale)}; }
    }
#endif
}
__device__ __forceinline__ att::BlockRef mem_ref(const Params& p, int L) {
    const int b = L >> 6, h = (L >> 4) & 3, qb = L & 15;
    att::BlockRef r;
    r.Q = (const bf16_t*)(p.ws + WS_QMEM) + (size_t)h * SLAB + ((size_t)b * SEQ + qb * 256) * 128;
    r.K = (const bf16_t*)(p.ws + WS_MEMKV) + (size_t)h * (NMEM * 128) + (size_t)b * MEM_LEN * 128;
    r.V = (const bf16_t*)(p.ws + WS_MEMKV) + (size_t)(4 + h) * (NMEM * 128) + (size_t)b * MEM_LEN * 128;
    r.O = (bf16_t*)(p.ws + WS_OMEM) + ((size_t)b * SEQ + qb * 256) * 512 + h * 128;
    r.P0 = 0;
    return r;
}
__device__ __forceinline__ void mem_attn_phase(const Params& p, char* lds) {
    const int total = 256, stride = gridDim.x;
    int L = blockIdx.x; if (L >= total) return;
    att::BlockRef cur = mem_ref(p, L);
    att::Seam S;
    att::attn_prime(cur, lds, S);
    for (;;) {
        const bool last = L + stride >= total;
        const att::BlockRef nxt = last ? cur : mem_ref(p, L + stride);
        att::attn_block<false>(cur, nxt, MEM_LEN, 512, p.in[I_MQN], lds, S);
        if (last) break;
        cur = nxt; L += stride;
    }
}

__device__ __forceinline__ unsigned f2key(float v) { const unsigned u = __float_as_uint(v); return (u & 0x80000000u) ? ~u : (u | 0x80000000u); }
__device__ __forceinline__ float key2f(unsigned k) { return __uint_as_float((k & 0x80000000u) ? (k & 0x7fffffffu) : ~k); }
#define KEY_INSERT(K, k_) do { unsigned nk_ = (k_); _Pragma("unroll") for (int s_ = 0; s_ < 16; ++s_) { const unsigned hi_ = K[s_] > nk_ ? K[s_] : nk_; nk_ = K[s_] > nk_ ? nk_ : K[s_]; K[s_] = hi_; } } while (0)
#define KEY_CE(a_, b_) do { const unsigned hi_ = (a_) > (b_) ? (a_) : (b_), lo_ = (a_) > (b_) ? (b_) : (a_); (a_) = hi_; (b_) = lo_; } while (0)
__device__ __forceinline__ void key_bitonic_merge16(unsigned (&a)[16]) {
#pragma unroll
    for (int j = 8; j > 0; j >>= 1)
#pragma unroll
        for (int i = 0; i < 16; ++i) { const int l = i ^ j; if (l > i) KEY_CE(a[i], a[l]); }
}
__device__ __forceinline__ void key_sort16(unsigned (&a)[16]) {
#pragma unroll
    for (int k = 2; k <= 16; k <<= 1)
#pragma unroll
        for (int j = k >> 1; j > 0; j >>= 1)
#pragma unroll
            for (int i = 0; i < 16; ++i) { const int l = i ^ j; if (l > i) { if ((i & k) == 0) KEY_CE(a[i], a[l]); else KEY_CE(a[l], a[i]); } }
}
__device__ __forceinline__ void key_top16_merge(unsigned (&K)[16], const unsigned (&T)[16]) {
#pragma unroll
    for (int s = 0; s < 16; ++s) K[s] = K[s] > T[15 - s] ? K[s] : T[15 - s];
    key_bitonic_merge16(K);
}
__device__ __forceinline__ void peer_topk_phase(const Params& p, LAS unsigned char* lds, int wid, int wave_gid, int nwaves) {
    const int lane = threadIdx.x & 63, r32 = lane & 31, hi = lane >> 5;
    const bf16_t* qp = (const bf16_t*)(p.ws + WS_P) + (size_t)64 * SLAB;
    const bf16_t* keys = (const bf16_t*)(p.ws + WS_KEYS);
    int* exps = (int*)(p.ws + WS_EXP); float* gates = (float*)(p.ws + WS_GATE);
    LAS unsigned* lk = (LAS unsigned*)(lds + wid * 8192);
    for (int task = wave_gid; task < (NTOK / 32) * 8; task += nwaves) {
        const int tile = task >> 3, h = task & 7, tok = tile * 32 + r32;
        unsigned K0[16], K1[16];
#pragma unroll 1
        for (int pp = 0; pp < 2; ++pp) {
            bf16x8 bq[8];
#pragma unroll
            for (int j = 0; j < 8; ++j) bq[j] = *(const bf16x8*)(qp + (size_t)tok * 2048 + h * 256 + pp * 128 + 16 * j + 8 * hi);
            unsigned K[16];
#pragma unroll
            for (int s = 0; s < 16; ++s) K[s] = 0u;
            const bf16_t* kb0 = keys + ((size_t)(h * 2 + pp) * 128 + r32) * 128 + 8 * hi;
            bf16x8 ka[8];
#pragma unroll
            for (int j = 0; j < 8; ++j) ka[j] = *(const bf16x8*)(kb0 + 16 * j);
#pragma unroll 1
            for (int i = 0; i < 4; ++i) {
                f32x16 acc = {};
#pragma unroll
                for (int j = 0; j < 8; ++j) acc = __builtin_amdgcn_mfma_f32_32x32x16_bf16(ka[j], bq[j], acc, 0, 0, 0);
                if (i < 3) {
#pragma unroll
                    for (int j = 0; j < 8; ++j) ka[j] = *(const bf16x8*)(kb0 + (size_t)(32 * (i + 1)) * 128 + 16 * j); }
                const unsigned pay0 = 127u - (unsigned)(32 * i + 4 * hi);
                unsigned T[16];
#pragma unroll
                for (int r = 0; r < 16; ++r) T[r] = (f2key(acc[r]) & ~127u) | (pay0 - (unsigned)((r & 3) + 8 * (r >> 2)));
                key_sort16(T); key_top16_merge(K, T);
            }
            unsigned O[16];
#pragma unroll
            for (int s = 0; s < 16; ++s) O[s] = (unsigned)__shfl_xor((int)K[s], 32);
            key_top16_merge(K, O);
#pragma unroll
            for (int s = 0; s < 16; ++s) { if (pp == 0) K0[s] = K[s]; else K1[s] = K[s]; }
        }
        float v0[16], v1[16];
#pragma unroll
        for (int s = 0; s < 16; ++s) { v0[s] = key2f(K0[s] & ~127u); v1[s] = key2f(K1[s] & ~127u); lk[s * 64 + lane] = K0[s]; lk[(16 + s) * 64 + lane] = K1[s]; }
#define CK(a_, b_) ((f2key(v0[a_] + v1[b_]) & ~255u) | (unsigned)(255 - (16 * (a_) + (b_))))
        unsigned B[16], T1[16], T2[16];
#pragma unroll
        for (int b2 = 0; b2 < 16; ++b2) B[b2] = CK(0, b2);
#pragma unroll
        for (int b2 = 0; b2 < 8; ++b2) T1[b2] = CK(1, b2);
#pragma unroll
        for (int b2 = 0; b2 < 5; ++b2) T1[8 + b2] = CK(2, b2);
#pragma unroll
        for (int b2 = 0; b2 < 3; ++b2) T1[13 + b2] = CK(3, b2);
        T2[0] = CK(3, 3);
#pragma unroll
        for (int b2 = 0; b2 < 3; ++b2) T2[1 + b2] = CK(4, b2);
#pragma unroll
        for (int a = 5; a < 8; ++a) { T2[4 + 2 * (a - 5)] = CK(a, 0); T2[5 + 2 * (a - 5)] = CK(a, 1); }
#pragma unroll
        for (int a = 8; a < 14; ++a) T2[10 + (a - 8)] = CK(a, 0);
        key_sort16(T1); key_top16_merge(B, T1);
        key_sort16(T2); key_top16_merge(B, T2);
        KEY_INSERT(B, CK(14, 0)); KEY_INSERT(B, CK(15, 0));
#undef CK
        float ev[16], den = 0.f; int ex[16];
        const float best = key2f(B[0] & ~255u);
#pragma unroll
        for (int s = 0; s < 16; ++s) {
            const unsigned pos = 255u - (B[s] & 255u);
            const unsigned ka = lk[(pos >> 4) * 64 + lane], kb2 = lk[(16 + (pos & 15)) * 64 + lane];
            ex[s] = (int)(((127u - (ka & 127u)) << 7) | (127u - (kb2 & 127u)));
            ev[s] = __expf(key2f(B[s] & ~255u) - best); den += ev[s];
        }
        const float inv = 1.0f / den;
        if (hi == 0) {
            int* ep = exps + (size_t)tok * 128 + h * 16; float* gp = gates + (size_t)tok * 128 + h * 16;
#pragma unroll
            for (int s4 = 0; s4 < 4; ++s4) {
                *(int4*)(ep + 4 * s4) = make_int4(ex[4 * s4], ex[4 * s4 + 1], ex[4 * s4 + 2], ex[4 * s4 + 3]);
                *(f32x4*)(gp + 4 * s4) = (f32x4){ev[4 * s4] * inv, ev[4 * s4 + 1] * inv, ev[4 * s4 + 2] * inv, ev[4 * s4 + 3] * inv};
            }
        }
    }
}

#if TAB_BITS == 8
constexpr int G_NJ = 4, G_EPJ = 16, G_R = 4;
#else
constexpr int G_NJ = 2, G_EPJ = 32, G_R = 4;
#endif
constexpr int G_JSTR = 64 * G_EPJ;
__device__ __forceinline__ void tab_dec(unsigned w, float (&o)[32 / TAB_BITS]) {
#if TAB_BITS == 8
    const f32x2 lo = __builtin_amdgcn_cvt_pk_f32_fp8((int)w, false), hi = __builtin_amdgcn_cvt_pk_f32_fp8((int)w, true);
    o[0] = lo.x; o[1] = lo.y; o[2] = hi.x; o[3] = hi.y;
#else
    const f32x2 a = __builtin_amdgcn_cvt_scalef32_pk_f32_fp4(w, 1.0f, 0), b = __builtin_amdgcn_cvt_scalef32_pk_f32_fp4(w, 1.0f, 1);
    const f32x2 c = __builtin_amdgcn_cvt_scalef32_pk_f32_fp4(w, 1.0f, 2), d = __builtin_amdgcn_cvt_scalef32_pk_f32_fp4(w, 1.0f, 3);
    o[0] = a.x; o[1] = a.y; o[2] = b.x; o[3] = b.y; o[4] = c.x; o[5] = c.y; o[6] = d.x; o[7] = d.y;
#endif
}
__device__ __forceinline__ float gelu_erf(float v) {
    const float av = fabsf(v), t = __builtin_amdgcn_rcpf(av * 0.2316418882f + 1.0f);
    float q = t * 0.5307027145f + (-0.7265760135f); q = q * t + 0.7107068705f; q = q * t + (-0.142248368f); q = q * t + 0.127414796f; q = q * t;
    const float e = __builtin_amdgcn_exp2f((v * v) * (-0.72134752044f));
    const float m = v * (q * e);
    return v < 0.f ? m : v - m;
}
#if TAB_BITS == 4
constexpr int GR_NS = 6, GR_RING = GR_NS * 2048, GR_H8 = 8 * GR_RING, GR_W = 131072 + 1024;
constexpr float H4_SCALE = 2.f;
__device__ __forceinline__ void peer_gather_phase(const Params& p, float* dst, LAS unsigned char* lds, int wid, int wave_gid, int nwaves) {
    const int lane = threadIdx.x & 63, l16 = lane & 15, g4 = lane >> 4;
    const unsigned char* u8 = p.ws + WS_P + (size_t)80 * SLAB * 2;
    const unsigned char* v8 = p.ws + (TAB_BITS == 4 ? WS_V4 : WS_HGO);
    const bf16_t* x2b = (const bf16_t*)(p.ws + WS_P);
    const int* exps = (const int*)(p.ws + WS_EXP); const float* gates = (const float*)(p.ws + WS_GATE);
    const unsigned long long* rowss2 = (const unsigned long long*)(p.ws + WS_ROWSS2);
    LAS unsigned char* ring = lds + wid * GR_RING;
    LAS unsigned char* h8 = lds + GR_H8 + wid * 4096;
    LAS float* wl = (LAS float*)(lds + GR_W + wid * 512);
    const unsigned rd0 = (unsigned)(uintptr_t)ring + (unsigned)lane * 16u;
    int tok = wave_gid; if (tok >= NTOK) return;
    int e0 = exps[(size_t)tok * 128 + lane], e1 = exps[(size_t)tok * 128 + 64 + lane];
#define G_ISSUE(ea, eb, slot, rs) do { const int e_ = __builtin_amdgcn_readlane((slot) < 64 ? (ea) : (eb), (slot) & 63); \
        const unsigned char* row_ = v8 + (size_t)e_ * TAB_ROW + lane * 16; \
        __builtin_amdgcn_global_load_lds((const unsigned*)row_, (LAS unsigned*)(ring + (rs) * 2048), 16, 0, 0); \
        __builtin_amdgcn_global_load_lds((const unsigned*)(row_ + 1024), (LAS unsigned*)(ring + (rs) * 2048 + 1024), 16, 0, 0); } while (0)
#define G_READ(ra, rb, addr) asm volatile("s_waitcnt vmcnt(10)\n\tds_read_b128 %0, %2\n\tds_read_b128 %1, %2 offset:1024\n\ts_waitcnt lgkmcnt(0)" : "=&v"(ra), "=&v"(rb) : "v"(addr) : "memory")
#pragma unroll
    for (int k = 0; k < GR_NS; ++k) G_ISSUE(e0, e1, k, k);
    int rs = 0;
    unsigned* tokq = (unsigned*)(p.ws + WS_CTL) + 3584;
    while (tok < NTOK) {
        unsigned nt_ = 0u; if (lane == 0) nt_ = (unsigned)nwaves + __hip_atomic_fetch_add(tokq, 1u, __ATOMIC_RELAXED, __HIP_MEMORY_SCOPE_AGENT);
        { const float r2 = rowscale(rowss2, tok) * H4_SCALE;
#pragma unroll
          for (int j = 0; j < 2; ++j) {
              u32x4 whi, wlo;
              f32x4 xq[8];
#pragma unroll
              for (int qq = 0; qq < 4; ++qq) bf8_f32(*(const u32x4*)(x2b + (size_t)tok * DM + j * 2048 + lane * 32 + 8 * qq), xq[2 * qq], xq[2 * qq + 1]);
#pragma unroll
              for (int q = 0; q < 8; ++q) {
                  const f32x4 xv = xq[q], gv = *(const f32x4*)(p.in[I_FFNN] + j * 2048 + lane * 32 + 4 * q);
                  const float h0 = xv[0] * gv[0] * r2, h1 = xv[1] * gv[1] * r2, h2 = xv[2] * gv[2] * r2, h3 = xv[3] * gv[3] * r2;
                  unsigned hb = 0u; hb = __builtin_amdgcn_cvt_scalef32_pk_fp4_f32(hb, h0, h1, 1.0f, 0); hb = __builtin_amdgcn_cvt_scalef32_pk_fp4_f32(hb, h2, h3, 1.0f, 1);
                  const f32x2 d01 = __builtin_amdgcn_cvt_scalef32_pk_f32_fp4(hb, 1.0f, 0), d23 = __builtin_amdgcn_cvt_scalef32_pk_f32_fp4(hb, 1.0f, 1);
                  unsigned lb = 0u; lb = __builtin_amdgcn_cvt_scalef32_pk_fp4_f32(lb, (h0 - d01.x) * 4.f, (h1 - d01.y) * 4.f, 1.0f, 0); lb = __builtin_amdgcn_cvt_scalef32_pk_fp4_f32(lb, (h2 - d23.x) * 4.f, (h3 - d23.y) * 4.f, 1.0f, 1);
                  if (q & 1) { whi[q >> 1] |= (hb & 0xffffu) << 16; wlo[q >> 1] |= (lb & 0xffffu) << 16; } else { whi[q >> 1] = hb & 0xffffu; wlo[q >> 1] = lb & 0xffffu; }
              }
              *(LAS u32x4*)(h8 + j * 1024 + lane * 16) = whi; *(LAS u32x4*)(h8 + 2048 + j * 1024 + lane * 16) = wlo;
          } }
        asm volatile("s_waitcnt lgkmcnt(0)" ::: "memory");
        {
            i32x4_t aL[16], aH[16];
            int elT[8], gtmp = 0;
#pragma unroll
            for (int T = 0; T < 8; ++T) elT[T] = exps[(size_t)tok * 128 + 16 * T + l16];
            (void)gtmp;
            const unsigned h8t0 = (unsigned)(uintptr_t)h8 + 16u * g4;
#define U_LOAD(buf, T_, half) do { const unsigned char* rp_ = u8 + (size_t)elT[T_] * TAB_ROW + g4 * 16 + (half) * 1024; \
            _Pragma("unroll") for (int t = 0; t < 16; ++t) buf[t] = *(const i32x4_t*)(rp_ + t * 64); } while (0)
#define U_MMA(buf, half) do { unsigned h8t = h8t0 + (half) * 1024u; asm volatile("" : "+v"(h8t)); \
            _Pragma("unroll") for (int t = 0; t < 16; ++t) { \
                const i32x4_t bh = *(const LAS i32x4_t*)(uintptr_t)(h8t + 64 * t), bl = *(const LAS i32x4_t*)(uintptr_t)(h8t + 2048 + 64 * t); \
                const pg8::i32x8 a8 = __builtin_shufflevector(buf[t], buf[t], 0, 1, 2, 3, -1, -1, -1, -1); \
                const pg8::i32x8 bh8 = __builtin_shufflevector(bh, bh, 0, 1, 2, 3, -1, -1, -1, -1), bl8 = __builtin_shufflevector(bl, bl, 0, 1, 2, 3, -1, -1, -1, -1); \
                acc = __builtin_amdgcn_mfma_scale_f32_16x16x128_f8f6f4(a8, bh8, acc, 4, 4, 0, 127, 0, 127); \
                acc = __builtin_amdgcn_mfma_scale_f32_16x16x128_f8f6f4(a8, bl8, acc, 4, 4, 0, 127, 0, 125); \
                if ((t & 3) == 3) __builtin_amdgcn_sched_barrier(0); } } while (0)
            U_LOAD(aL, 0, 0); U_LOAD(aH, 0, 1);
#pragma unroll
            for (int T = 0; T < 8; ++T) {
                f32x4 acc = {0.f, 0.f, 0.f, 0.f};
                __builtin_amdgcn_sched_barrier(0);
                U_MMA(aL, 0);
                if (T < 7) U_LOAD(aL, T + 1, 0);
                __builtin_amdgcn_sched_barrier(0);
                U_MMA(aH, 1);
                if (T < 7) U_LOAD(aH, T + 1, 1);
                __builtin_amdgcn_sched_barrier(0);
                f32x4 w4;
#pragma unroll
                for (int j = 0; j < 4; ++j) w4[j] = acc[j];
                *(LAS f32x4*)(wl + 16 * T + 4 * g4) = w4;
            }
#undef U_LOAD
#undef U_MMA
        }
        const int ntok = __builtin_amdgcn_readfirstlane((int)nt_); const bool has_next = ntok < NTOK;
        int e0n = e0, e1n = e1;
        if (has_next) { e0n = exps[(size_t)ntok * 128 + lane]; e1n = exps[(size_t)ntok * 128 + 64 + lane]; }
        asm volatile("s_waitcnt lgkmcnt(0)" ::: "memory");
        const float w0 = gelu_erf(wl[lane] * (1.0f / (H4_SCALE * U_SCALE))) * gates[(size_t)tok * 128 + lane] * (1.0f / V_SCALE);
        const float w1 = gelu_erf(wl[64 + lane] * (1.0f / (H4_SCALE * U_SCALE))) * gates[(size_t)tok * 128 + 64 + lane] * (1.0f / V_SCALE);
        float y[64];
#pragma unroll
        for (int i = 0; i < 64; ++i) y[i] = 0.f;
        for (int slot = 0; slot < 128; ++slot) {
            u32x4 ra, rb; G_READ(ra, rb, rd0 + (unsigned)rs * 2048u);
            if (slot + GR_NS < 128) G_ISSUE(e0, e1, slot + GR_NS, rs); else G_ISSUE(e0n, e1n, slot + GR_NS - 128, rs);
            const float w = rdlane(slot < 64 ? w0 : w1, slot & 63);
#pragma unroll
            for (int q = 0; q < 4; ++q) { float d[8]; tab_dec(ra[q], d);
#pragma unroll
                for (int i = 0; i < 8; ++i) y[q * 8 + i] = fmaf(w, d[i], y[q * 8 + i]); }
#pragma unroll
            for (int q = 0; q < 4; ++q) { float d[8]; tab_dec(rb[q], d);
#pragma unroll
                for (int i = 0; i < 8; ++i) y[32 + q * 8 + i] = fmaf(w, d[i], y[32 + q * 8 + i]); }
            rs = (rs + 1 == GR_NS) ? 0 : rs + 1;
        }
        const bf16_t* op = x2b + (size_t)tok * DM + lane * 32; float* dp = dst + (size_t)tok * DM + lane * 32;
#pragma unroll
        for (int j = 0; j < 2; ++j)
#pragma unroll
            for (int qq = 0; qq < 4; ++qq) {
                f32x4 v0, v1; bf8_f32(*(const u32x4*)(op + j * 2048 + 8 * qq), v0, v1);
#pragma unroll
                for (int i = 0; i < 4; ++i) { v0[i] += y[j * 32 + 8 * qq + i]; v1[i] += y[j * 32 + 8 * qq + 4 + i]; }
                *(f32x4*)(dp + j * 2048 + 8 * qq) = v0; *(f32x4*)(dp + j * 2048 + 8 * qq + 4) = v1;
            }
        e0 = e0n; e1 = e1n; tok = ntok;
    }
    asm volatile("s_waitcnt vmcnt(0)" ::: "memory");
#undef G_ISSUE
#undef G_READ
}
#else
static_assert(TAB_BITS == 4, "the 8-bit-table gather below still reads an f32 x2 from d_out: the residual stream is bf16 now");
__device__ __forceinline__ void peer_gather_phase(const Params& p, float* dst, LAS unsigned char*, int, int wave_gid, int nwaves) {
    constexpr int EPD = 32 / TAB_BITS;
    const int lane = threadIdx.x & 63;
    const unsigned char* u8 = p.ws + WS_P + (size_t)80 * SLAB * 2;
    const unsigned char* v8 = p.ws + (TAB_BITS == 4 ? WS_V4 : WS_HGO);
    const int* exps = (const int*)(p.ws + WS_EXP); const float* gates = (const float*)(p.ws + WS_GATE);
    const unsigned long long* rowss2 = (const unsigned long long*)(p.ws + WS_ROWSS2);
    for (int tok = wave_gid; tok < NTOK; tok += nwaves) {
        const float r2 = rowscale(rowss2, tok) * (1.0f / U_SCALE);
        float h[64];
#pragma unroll
        for (int j = 0; j < G_NJ; ++j)
#pragma unroll
            for (int q = 0; q < G_EPJ / 4; ++q) {
                const f32x4 xv = *(const f32x4*)(p.out + (size_t)tok * DM + j * G_JSTR + lane * G_EPJ + 4 * q), gv = *(const f32x4*)(p.in[I_FFNN] + j * G_JSTR + lane * G_EPJ + 4 * q);
                h[j * G_EPJ + 4 * q] = xv[0] * gv[0] * r2; h[j * G_EPJ + 4 * q + 1] = xv[1] * gv[1] * r2; h[j * G_EPJ + 4 * q + 2] = xv[2] * gv[2] * r2; h[j * G_EPJ + 4 * q + 3] = xv[3] * gv[3] * r2;
                if ((q & 3) == 3) __builtin_amdgcn_sched_barrier(0);
            }
        const int e0 = exps[(size_t)tok * 128 + lane], e1 = exps[(size_t)tok * 128 + 64 + lane];
        const float g0 = gates[(size_t)tok * 128 + lane], g1 = gates[(size_t)tok * 128 + 64 + lane];
        float w0 = 0.f, w1 = 0.f;
        for (int grp = 0; grp < 128 / G_R; ++grp) {
            u32x4 rb[G_R][G_NJ];
#pragma unroll
            for (int r = 0; r < G_R; ++r) {
                const int slot = grp * G_R + r;
                const int e = __builtin_amdgcn_readlane(slot < 64 ? e0 : e1, slot & 63);
                const unsigned char* row = u8 + (size_t)e * TAB_ROW + lane * 16;
#pragma unroll
                for (int j = 0; j < G_NJ; ++j) rb[r][j] = *(const u32x4*)(row + j * 1024);
            }
#pragma unroll
            for (int r = 0; r < G_R; ++r) {
                float acc = 0.f;
#pragma unroll
                for (int j = 0; j < G_NJ; ++j)
#pragma unroll
                    for (int q = 0; q < 4; ++q) {
                        float d[EPD]; tab_dec(rb[r][j][q], d);
#pragma unroll
                        for (int i = 0; i < EPD; ++i) acc = fmaf(d[i], h[j * G_EPJ + q * EPD + i], acc);
                    }
                const float a = wave_allsum(acc);
                const int slot = grp * G_R + r;
                if (slot < 64) { if (lane == (slot & 63)) w0 = a; } else { if (lane == (slot & 63)) w1 = a; }
                __builtin_amdgcn_sched_barrier(0);
            }
        }
        w0 = gelu_erf(w0) * g0 * (1.0f / V_SCALE); w1 = gelu_erf(w1) * g1 * (1.0f / V_SCALE);
        float y[64];
#pragma unroll
        for (int i = 0; i < 64; ++i) y[i] = 0.f;
        for (int grp = 0; grp < 128 / G_R; ++grp) {
            u32x4 rb[G_R][G_NJ];
#pragma unroll
            for (int r = 0; r < G_R; ++r) {
                const int slot = grp * G_R + r;
                const int e = __builtin_amdgcn_readlane(slot < 64 ? e0 : e1, slot & 63);
                const unsigned char* row = v8 + (size_t)e * TAB_ROW + lane * 16;
#pragma unroll
                for (int j = 0; j < G_NJ; ++j) rb[r][j] = *(const u32x4*)(row + j * 1024);
            }
#pragma unroll
            for (int r = 0; r < G_R; ++r) {
                const int slot = grp * G_R + r;
                const float w = rdlane(slot < 64 ? w0 : w1, slot & 63);
#pragma unroll
                for (int j = 0; j < G_NJ; ++j)
#pragma unroll
                    for (int q = 0; q < 4; ++q) {
                        float d[EPD]; tab_dec(rb[r][j][q], d);
#pragma unroll
                        for (int i = 0; i < EPD; ++i) y[j * G_EPJ + q * EPD + i] = fmaf(w, d[i], y[j * G_EPJ + q * EPD + i]);
                    }
                __builtin_amdgcn_sched_barrier(0);
            }
        }
        const float* op = p.out + (size_t)tok * DM + lane * G_EPJ; float* dp = dst + (size_t)tok * DM + lane * G_EPJ;
#pragma unroll
        for (int j = 0; j < G_NJ; ++j)
#pragma unroll
            for (int q = 0; q < G_EPJ / 4; ++q) {
                f32x4 v = *(const f32x4*)(op + j * G_JSTR + 4 * q);
                v[0] += y[j * G_EPJ + 4 * q]; v[1] += y[j * G_EPJ + 4 * q + 1]; v[2] += y[j * G_EPJ + 4 * q + 2]; v[3] += y[j * G_EPJ + 4 * q + 3];
                *(f32x4*)(dp + j * G_JSTR + 4 * q) = v;
            }
    }
}

#endif

#ifndef MIXP
#define MIXP 7
#endif

#ifndef PROJ_F8
#define PROJ_F8 false
#endif
#ifndef MEMKV_IN_P2
#define MEMKV_IN_P2 (N_LAUNCHES == 1)
#endif
#ifndef PROBE_DUP
#define PROBE_DUP 0
#endif
#ifndef DBG_STOP
#define DBG_STOP DBG_DUMP
#endif
#ifndef DBG_SAN
#define DBG_SAN 0
#endif
#ifndef DBG_DUMP
#define DBG_DUMP 11
#endif
#ifndef DBG_SUB
#define DBG_SUB 2
#endif
#ifndef PH_MASK
#define PH_MASK ((2u << DBG_STOP) - 1u)
#endif
constexpr int LDS_ARGS = LDS_MISC + 64;
__device__ __forceinline__ unsigned char* lds_arg(LAS unsigned char* lds, int i) {
    const LAS unsigned* q = (const LAS unsigned*)(lds + LDS_ARGS + 8 * i);
    const unsigned lo = __builtin_amdgcn_readfirstlane(q[0]), hi = __builtin_amdgcn_readfirstlane(q[1]);
    return (unsigned char*)(__attribute__((address_space(1))) unsigned char*)(((unsigned long long)hi << 32) | lo);
}
__device__ __forceinline__ void load_params(LAS unsigned char* lds, Params& p) {
#pragma unroll
    for (int i = 0; i < 27; ++i) p.in[i] = (const float*)lds_arg(lds, i);
    p.out = (float*)lds_arg(lds, 27); p.ws = lds_arg(lds, 28); p.ph_lo = 0; p.ph_hi = 0;
}
__global__ void __launch_bounds__(512, 2) fwd_kernel(Params pk) {
    extern __shared__ __attribute__((aligned(16))) unsigned char lds_raw[];
    LAS unsigned char* lds = (LAS unsigned char*)lds_raw;
    const int tid = threadIdx.x, wid = __builtin_amdgcn_readfirstlane(tid >> 6);
    const int G = gridDim.x, wg = blockIdx.x;
    const int wave_gid = wg * 8 + wid, nwaves = G * 8;
    if (tid == 0) {
        LAS unsigned long long* a = (LAS unsigned long long*)(lds + LDS_ARGS);
#pragma unroll
        for (int i = 0; i < 27; ++i) a[i] = (unsigned long long)pk.in[i];
        a[27] = (unsigned long long)pk.out; a[28] = (unsigned long long)pk.ws; a[29] = ((unsigned long long)(unsigned)pk.ph_hi << 32) | (unsigned)pk.ph_lo;
        LAS unsigned* m = (LAS unsigned*)(lds + LDS_MISC); m[0] = 0u; m[1] = 0u; m[2] = 0u; m[3] = 0u;
    }
    __syncthreads();
    if (N_LAUNCHES == 1) { (void)xcd_barrier_post((unsigned*)(lds_arg(lds, 28) + WS_CTL), (volatile LAS unsigned*)(lds + LDS_MISC)); }
#define GRID_BAR() do { if (N_LAUNCHES == 1) { XcdBarrier bar_; bar_.bar = (unsigned*)(lds_arg(lds, 28) + WS_CTL); bar_.x = xb_xcc_id(); bar_.st = (volatile LAS unsigned*)(lds + LDS_MISC); xcd_barrier(bar_); } } while (0)
#define LOADP() Params p; load_params(lds, p); unsigned char* const ws = p.ws; bf16_t* const Pslab = (bf16_t*)(ws + WS_P); (void)Pslab
    int lo, hi; { const unsigned long long lh = lds_arg(lds, 29) - (unsigned char*)0; lo = (int)(unsigned)lh; hi = (int)(unsigned)(lh >> 32); }
#define IN(k) ((((PH_MASK) >> (k)) & 1) && lo <= (k) && (k) < hi)
#define BOTH(k) (IN(k) && IN((k) + 1))

    if (IN(0)) {
        LOADP();
        for (int rep_ = 0; rep_ < (PROBE_DUP == 100 ? 2 : 1); ++rep_) {
        if (MIXP == 7) transpose_cvt<2>(p.in[I_WIN], DM, IN_COLS, IN_COLS, ws + WS_WIN, DM, 0, W_I8, lds, wg, G);
        else if (MIXP == 6) { transpose_cvt<false>(p.in[I_WIN], DM, 6144, IN_COLS, ws + WS_WIN, DM, 0, 1.f, lds, wg, G);
                         transpose_cvt<true>(p.in[I_WIN] + 6144, DM, 8192, IN_COLS, ws + WS_WIN8E, DM, 0, W_SCALE, lds, wg, G); }
        else if (MIXP == 5) { transpose_cvt<false>(p.in[I_WIN], DM, 8192, IN_COLS, ws + WS_WIN, DM, 0, 1.f, lds, wg, G);
                         transpose_cvt<false>(p.in[I_WIN] + 10240, DM, 4096, IN_COLS, ws + WS_WIN, DM, 8192, 1.f, lds, wg, G);
                         transpose_cvt<true>(p.in[I_WIN] + 8192, DM, 2048, IN_COLS, ws + WS_WIN8D, DM, 0, W_SCALE, lds, wg, G); }
        else if (MIXP == 4) { transpose_cvt<false>(p.in[I_WIN] + 8192, DM, 2048, IN_COLS, ws + WS_WIN, DM, 0, 1.f, lds, wg, G);
                         transpose_cvt<true>(p.in[I_WIN], DM, 8192, IN_COLS, ws + WS_WIN8C, DM, 0, W_SCALE, lds, wg, G);
                         transpose_cvt<true>(p.in[I_WIN] + 10240, DM, 4096, IN_COLS, ws + WS_WIN8C, DM, 8192, W_SCALE, lds, wg, G); }
        else if (MIXP == 3) { transpose_cvt<false>(p.in[I_WIN] + 4096, DM, 10240, IN_COLS, ws + WS_WIN, DM, 0, 1.f, lds, wg, G);
                         transpose_cvt<true>(p.in[I_WIN], DM, 4096, IN_COLS, ws + WS_WIN8B, DM, 0, W_SCALE, lds, wg, G); }
        else if (MIXP == 2) transpose_cvt<true>(p.in[I_WIN], DM, IN_COLS, IN_COLS, ws + WS_WIN, DM, 0, W_SCALE, lds, wg, G);
        else if (MIXP == 1) {
            const float* wi = p.in[I_WIN];
            transpose_cvt<false>(wi + 2 * 2048, DM, 2048, IN_COLS, ws + WS_WIN, DM, 0, 1.f, lds, wg, G);
            transpose_cvt<false>(wi + 3 * 2048, DM, 2048, IN_COLS, ws + WS_WIN, DM, 2048, 1.f, lds, wg, G);
            transpose_cvt<false>(wi + 5 * 2048, DM, 2048, IN_COLS, ws + WS_WIN, DM, 4096, 1.f, lds, wg, G);
            transpose_cvt<false>(wi + 6 * 2048, DM, 2048, IN_COLS, ws + WS_WIN, DM, 6144, 1.f, lds, wg, G);
            transpose_cvt<true>(wi + 0 * 2048, DM, 2048, IN_COLS, ws + WS_WIN8, DM, 0, W_SCALE, lds, wg, G);
            transpose_cvt<true>(wi + 1 * 2048, DM, 2048, IN_COLS, ws + WS_WIN8, DM, 2048, W_SCALE, lds, wg, G);
            transpose_cvt<true>(wi + 4 * 2048, DM, 2048, IN_COLS, ws + WS_WIN8, DM, 4096, W_SCALE, lds, wg, G);
        } else transpose_cvt<false>(p.in[I_WIN], DM, IN_COLS, IN_COLS, ws + WS_WIN, DM, 0, 1.f, lds, wg, G);
        transpose_cvt<WO_MODE>(p.in[I_WOUT], DM, DM, DM, ws + WS_WOUT, DM, 0, WO_MODE == 2 ? W_I8 : 1.f, lds, wg, G);
        transpose_cvt<MQ_MODE>(p.in[I_WMQ], DM, 512, 512, ws + WS_WMQ, DM, 0, MQ_MODE == 2 ? W_I8 : (MQ_MODE == 1 ? W_SCALE : 1.f), lds, wg, G);
        transpose_cvt<2>(p.in[I_WMK], DM, 512, 512, ws + WS_WMKV, DM, 0, W_I8, lds, wg, G);
        transpose_cvt<2>(p.in[I_WMV], DM, 512, 512, ws + WS_WMKV, DM, 512, W_I8, lds, wg, G);
        transpose_cvt<false>(p.in[I_WMO], 512, DM, DM, ws + WS_WMO, 512, 0, 1.f, lds, wg, G);
        transpose_cvt<PQ_MODE, PQ_MODE == 0>(p.in[I_PWQ], DM, 2048, 2048, ws + WS_WPQ, DM, 0, PQ_MODE == 2 ? W_I8 : (PQ_MODE == 1 ? W_SCALE : 1.f), lds, wg, G, p.in[I_FFNN]);
        if (MIXP == 7) rmsnorm_rows_i8(p.in[I_X], p.in[I_MIXN], ws + WS_HGO, NTOK, wave_gid, nwaves, lds);
        else rmsnorm_rows<MIXP == 7 ? 3 : (MIXP == 2 ? 1 : (MIXP == 1 || MIXP >= 3 ? 2 : 0))>(p.in[I_X], p.in[I_MIXN], (MIXP == 2 || MIXP == 7) ? ws + WS_HGO : ws + WS_A, ws + WS_HGO, NTOK, wave_gid, nwaves);
        rmsnorm_rows_i8(p.in[I_MEM], p.in[I_MEMKVN], ws + WS_MEMN, NMEM, wave_gid, nwaves, lds);
        { bf16_t* kd = (bf16_t*)(ws + WS_KEYS); const float* ks = p.in[I_PKEYS];
          for (int i = wg * 512 + tid; i < 8 * 2 * 128 * 128; i += G * 512) kd[i] = f2bf(ks[i]); }
        }
        if (BOTH(0)) GRID_BAR();
    }
    if (IN(1)) {
        LOADP();
        if (MIXP == 7) {
            pg8::Gemm g{ws + WS_HGO, ws + WS_WIN, NTOK, IN_COLS, DM, DM, DM}; pg8::StaticOrder S; S.init(NTOK, IN_COLS, G, wg);
            pg8::EpiBf16S E{Pslab, nullptr, 1, SLAB, 0, 1.0f / (H_I8 * W_I8), 1 << 30, 0, 0, p.in[I_DKN], SL_DK, SL_DK + 16, (LAS float*)(lds + KN_LDS)};
            pg8::gemm_phase<pg8::EpiBf16S, 2>(lds, g, S, E);
        } else if (MIXP == 6) {
            { pg8::Gemm g{ws + WS_A, ws + WS_WIN, NTOK, 6144, DM, DM * 2, DM * 2}; pg8::StaticOrder S; S.init(NTOK, 6144, G, wg);
              pg8::EpiBf16S E{Pslab, nullptr, 1, SLAB, 0, 1.0f, 1 << 30, 0, 0};
              pg8::gemm_phase<pg8::EpiBf16S, false>(lds, g, S, E); }
            { pg8::Gemm g{ws + WS_HGO, ws + WS_WIN8E, NTOK, 8192, DM, DM, DM}; pg8::StaticOrder S; S.init(NTOK, 8192, G, wg);
              pg8::EpiBf16S E{Pslab, nullptr, 1, SLAB, 0, 1.0f / (H_SCALE * W_SCALE), 1 << 30, 48, 48};
              pg8::gemm_phase<pg8::EpiBf16S, true>(lds, g, S, E); }
        } else if (MIXP == 5) {
            { pg8::Gemm g{ws + WS_A, ws + WS_WIN, NTOK, 12288, DM, DM * 2, DM * 2}; pg8::StaticOrder S; S.init(NTOK, 12288, G, wg);
              pg8::EpiBf16S E{Pslab, nullptr, 1, SLAB, 0, 1.0f, 64, 0, 16};
              pg8::gemm_phase<pg8::EpiBf16S, false>(lds, g, S, E); }
            { pg8::Gemm g{ws + WS_HGO, ws + WS_WIN8D, NTOK, 2048, DM, DM, DM}; pg8::StaticOrder S; S.init(NTOK, 2048, G, wg);
              pg8::EpiBf16S E{Pslab, nullptr, 1, SLAB, 0, 1.0f / (H_SCALE * W_SCALE), 1 << 30, 64, 64};
              pg8::gemm_phase<pg8::EpiBf16S, true>(lds, g, S, E); }
        } else if (MIXP == 4) {
            { pg8::Gemm g{ws + WS_A, ws + WS_WIN, NTOK, 2048, DM, DM * 2, DM * 2}; pg8::StaticOrder S; S.init(NTOK, 2048, G, wg);
              pg8::EpiBf16S E{Pslab, nullptr, 1, SLAB, 0, 1.0f, 1 << 30, 64, 64};
              pg8::gemm_phase<pg8::EpiBf16S, false>(lds, g, S, E); }
            { pg8::Gemm g{ws + WS_HGO, ws + WS_WIN8C, NTOK, 12288, DM, DM, DM}; pg8::StaticOrder S; S.init(NTOK, 12288, G, wg);
              pg8::EpiBf16S E{Pslab, nullptr, 1, SLAB, 0, 1.0f / (H_SCALE * W_SCALE), 64, 0, 16};
              pg8::gemm_phase<pg8::EpiBf16S, true>(lds, g, S, E); }
        } else if (MIXP == 3) {
            { pg8::Gemm g{ws + WS_A, ws + WS_WIN, NTOK, 10240, DM, DM * 2, DM * 2}; pg8::StaticOrder S; S.init(NTOK, 10240, G, wg);
              pg8::EpiBf16S E{Pslab, nullptr, 1, SLAB, 0, 1.0f, 1 << 30, 32, 32};
              pg8::gemm_phase<pg8::EpiBf16S, false>(lds, g, S, E); }
            { pg8::Gemm g{ws + WS_HGO, ws + WS_WIN8B, NTOK, 4096, DM, DM, DM}; pg8::StaticOrder S; S.init(NTOK, 4096, G, wg);
              pg8::EpiBf16S E{Pslab, nullptr, 1, SLAB, 0, 1.0f / (H_SCALE * W_SCALE), 1 << 30, 0, 0};
              pg8::gemm_phase<pg8::EpiBf16S, true>(lds, g, S, E); }
        } else if (MIXP == 2) {
            pg8::Gemm g{ws + WS_HGO, ws + WS_WIN, NTOK, IN_COLS, DM, DM, DM}; pg8::StaticOrder S; S.init(NTOK, IN_COLS, G, wg);
            pg8::EpiBf16S E{Pslab, nullptr, 1, SLAB, 0, 1.0f / (H_SCALE * W_SCALE), 1 << 30, 0, 0};
            pg8::gemm_phase<pg8::EpiBf16S, true>(lds, g, S, E);
        } else if (MIXP == 1) {
            { pg8::Gemm g{ws + WS_A, ws + WS_WIN, NTOK, 8192, DM, DM * 2, DM * 2}; pg8::StaticOrder S; S.init(NTOK, 8192, G, wg);
              pg8::EpiBf16S E{Pslab, nullptr, 1, SLAB, 0, 1.0f, 32, 32, 48};
              pg8::gemm_phase<pg8::EpiBf16S, false>(lds, g, S, E); }
            { pg8::Gemm g{ws + WS_HGO, ws + WS_WIN8, NTOK, 6144, DM, DM, DM}; pg8::StaticOrder S; S.init(NTOK, 6144, G, wg);
              pg8::EpiBf16S E{Pslab, nullptr, 1, SLAB, 0, 1.0f / (H_SCALE * W_SCALE), 32, 0, 32};
              pg8::gemm_phase<pg8::EpiBf16S, true>(lds, g, S, E); }
        } else {
            pg8::Gemm g{ws + WS_A, ws + WS_WIN, NTOK, IN_COLS, DM, DM * 2, DM * 2}; pg8::StaticOrder S; S.init(NTOK, IN_COLS, G, wg);
            pg8::EpiBf16S E{Pslab, nullptr, 1, SLAB, 0, 1.0f, 1 << 30, 0, 0};
            pg8::gemm_phase<pg8::EpiBf16S, false>(lds, g, S, E);
        }
        if (!MEMKV_IN_P2 || MIXP != 7 || G < 32) {
          pg8::Gemm g{ws + WS_MEMN, ws + WS_WMKV, NMEM, 1024, DM, DM, DM}; pg8::StaticOrder S; S.init(NMEM, 1024, G, wg);
          pg8::EpiBf16S E{(bf16_t*)(ws + WS_MEMKV), nullptr, 1, (size_t)NMEM * 128, 0, 1.0f / (H_I8 * W_I8), 1 << 30, 0, 0, p.in[I_MKN], 0, 4, (LAS float*)(lds + KN_LDS)};
          pg8::gemm_phase<pg8::EpiBf16S, 2>(lds, g, S, E);
          if (TAB_BITS == 4 && wg >= 16) cvt_fp8_table(p.in[I_PV], ws + WS_V4, V_SCALE, (wg - 16) * 512 + tid, (G - 16) * 512);
        } else if (TAB_BITS == 4) cvt_fp8_table(p.in[I_PV], ws + WS_V4, V_SCALE, wg * 512 + tid, G * 512);
        if (BOTH(1)) GRID_BAR();
    }
    if (IN(2)) {
        LOADP();
        if (MIXP != 7) { knorm_rows(Pslab + (size_t)SL_DK * SLAB, (size_t)16 * NTOK, p.in[I_DKN], wave_gid, nwaves);
                         knorm_rows((bf16_t*)(ws + WS_MEMKV), (size_t)4 * NMEM, p.in[I_MKN], wave_gid, nwaves); }
        if (MEMKV_IN_P2 && MIXP == 7 && G >= 32) {
            if (wg < 16) { pg8::Gemm g{ws + WS_MEMN, ws + WS_WMKV, NMEM, 1024, DM, DM, DM}; pg8::StaticOrder S; S.init(NMEM, 1024, 16, wg);
                pg8::EpiBf16S E{(bf16_t*)(ws + WS_MEMKV), nullptr, 1, (size_t)NMEM * 128, 0, 1.0f / (H_I8 * W_I8), 1 << 30, 0, 0, p.in[I_MKN], 0, 4, (LAS float*)(lds + KN_LDS)};
                pg8::gemm_phase<pg8::EpiBf16S, 2>(lds, g, S, E); }
            else hgrn_prepass(p, lds, wg - 16, G - 16);
        } else hgrn_prepass(p, lds, wg, G);
        if (BOTH(2)) GRID_BAR();
    }
    if (IN(3)) {
        LOADP();
        for (int rep_ = 0; rep_ < (PROBE_DUP == 31 ? 2 : 1); ++rep_)
        for (int u = wg; u < 256; u += G) { const int uu = (G == 256) ? ((((u >> 5) * 8 + (u & 7)) << 2) | ((u >> 3) & 3)) : u;
            hgrn_unit(p, uu, lds); __syncthreads(); }
        diff_attn_phase(p, (char*)lds_raw, lds);
        if (BOTH(3)) GRID_BAR();
    }
    if (IN(4)) {
        LOADP();
        mixfinal_phase(p, wave_gid, nwaves);
        if (BOTH(4)) GRID_BAR();
    }
    if (IN(5)) {
        LOADP();
        pg8::Gemm g{ws + WS_P, ws + WS_WOUT, NTOK, DM, DM, DM * (WO_MODE == 2 ? 1 : 2), DM * (WO_MODE == 2 ? 1 : 2)}; pg8::StaticOrder S; S.init(NTOK, DM, G, wg);
        pg8::EpiResid<MQ_MODE, false> E{p.in[I_X], Pslab + (size_t)32 * SLAB, ws + WS_A, p.in[I_MEMN], (unsigned long long*)(ws + WS_ROWSS1), WO_MODE == 2 ? 1.0f / (MIX_I8 * W_I8) : 1.0f};
        pg8::gemm_phase<pg8::EpiResid<MQ_MODE, false>, WO_MODE>(lds, g, S, E);
        if (BOTH(5)) GRID_BAR();
    }
    if (IN(6)) {
        LOADP();
        constexpr int EB = MQ_MODE != 0 ? 1 : 2;
        pg8::Gemm g{ws + WS_A, ws + WS_WMQ, NTOK, 512, DM, DM * EB, DM * EB}; pg8::StaticOrder S; S.init(NTOK, 512, G, wg);
        pg8::EpiBf16S E{(bf16_t*)(ws + WS_QMEM), (const unsigned long long*)(ws + WS_ROWSS1), 1, SLAB, 0, MQ_MODE == 2 ? 1.0f / (XG_I8 * W_I8) : (MQ_MODE == 1 ? 1.0f / (XG_SCALE * W_SCALE) : 1.0f), 1 << 30, 0, 0};
        pg8::gemm_phase<pg8::EpiBf16S, MQ_MODE>(lds, g, S, E);
        if (TAB_BITS == 4 && wg >= 128) cvt_fp8_table(p.in[I_PU], ws + WS_P + (size_t)80 * SLAB * 2, U_SCALE, (wg - 128) * 512 + tid, (G - 128) * 512);
        if (BOTH(6)) GRID_BAR();
    }
    if (IN(7)) {
        LOADP();
        mem_attn_phase(p, (char*)lds_raw);
        if (TAB_BITS != 4) { cvt_fp8_table(p.in[I_PU], ws + WS_P + (size_t)80 * SLAB * 2, U_SCALE, wg * 512 + tid, G * 512);
                             cvt_fp8_table(p.in[I_PV], ws + WS_HGO, V_SCALE, wg * 512 + tid, G * 512); }
        if (BOTH(7)) GRID_BAR();
    }
    if (IN(8)) {
        LOADP();
        pg8::Gemm g{ws + WS_OMEM, ws + WS_WMO, NTOK, DM, 512, 1024, 1024}; pg8::StaticOrder S; S.init(NTOK, DM, G, wg);
        constexpr int G8_ = PQ_MODE != 0 ? PQ_MODE : -1;
        pg8::EpiResid<G8_, true> E{Pslab + (size_t)32 * SLAB, Pslab, ws + WS_A, p.in[I_FFNN], (unsigned long long*)(ws + WS_ROWSS2), 1.0f};
        pg8::gemm_phase<pg8::EpiResid<G8_, true>, false>(lds, g, S, E);
        if (BOTH(8)) GRID_BAR();
    }
    if (IN(9)) {
        LOADP();
        constexpr int EB = PQ_MODE != 0 ? 1 : 2;
        pg8::Gemm g{PQ_MODE != 0 ? (const void*)(ws + WS_A) : (const void*)Pslab, ws + WS_WPQ, NTOK, 2048, DM, DM * EB, DM * EB}; pg8::StaticOrder S; S.init(NTOK, 2048, G, wg);
        pg8::EpiBf16S E{Pslab + (size_t)64 * SLAB, (const unsigned long long*)(ws + WS_ROWSS2), 0, 0, 2048, PQ_MODE == 2 ? 1.0f / (XG_I8 * W_I8) : (PQ_MODE == 1 ? 1.0f / (XG_SCALE * W_SCALE) : 1.0f), 1 << 30, 0, 0};
        pg8::gemm_phase<pg8::EpiBf16S, PQ_MODE>(lds, g, S, E);
        if (BOTH(9)) GRID_BAR();
    }
    if (IN(10)) {
        LOADP();
        peer_topk_phase(p, lds, wid, wave_gid, nwaves);
        if (BOTH(10)) GRID_BAR();
    }
    if (IN(11)) {
        LOADP();
#if PROBE_DUP == 11
        peer_gather_phase(p, (float*)(ws + WS_A), lds, wid, wave_gid, nwaves);
#endif
        peer_gather_phase(p, p.out, lds, wid, wave_gid, nwaves);
    }
#if DBG_SAN
    if (hi == NPHASE + 1) {
        LOADP();
        const size_t n = (size_t)NTOK * DM;
        for (size_t i = (size_t)wg * 512 + tid; i < n; i += (size_t)G * 512) {
            const size_t tok = i / DM; const int c = (int)(i % DM);
            float v;
#if DBG_DUMP == 0
            v = bf2f(((const bf16_t*)(ws + WS_A))[i]);
#elif DBG_DUMP == 1 || DBG_DUMP == 2
            v = 0.f;
            for (int g = 0; g < 4; ++g) { const int sl = 32 * g + c / 128; if (sl < NSLAB) v += bf2f(Pslab[(size_t)sl * SLAB + tok * 128 + (c & 127)]); }
#elif DBG_DUMP == 3
            v = 0.f;
            if (DBG_SUB != 2) v = bf2f(((const bf16_t*)(ws + WS_A))[(size_t)(c / 128) * SLAB + tok * 128 + (c & 127)]);
            if (DBG_SUB != 1 && c < 2048) v += bf2f(((const bf16_t*)(ws + WS_HGO))[tok * 2048 + c]);
#elif DBG_DUMP == 4
            v = bf2f(Pslab[i]);
#else
            v = (DBG_STOP < 5) ? p.in[I_X][i] : p.out[i];
#endif
            if (!(fabsf(v) < 1e30f)) v = 100.f;
            p.out[i] = v;
        }
    }
#endif
#undef IN
#undef BOTH
#undef GRID_BAR
}

extern "C" void kernel_launch(void* const* d_in, const int* in_sizes, int n_in, void* d_out, int out_size, void* d_ws, size_t ws_size, hipStream_t stream) {
    static int grid = 0;
    if (grid == 0) {
        if (n_in != 27 || out_size != NTOK * DM || ws_size < WS_END2) { fprintf(stderr, "kernel_launch: unexpected shapes (n_in %d out %d ws %zu need %zu)\n", n_in, out_size, ws_size, (size_t)WS_END2); grid = -1; return; }
        int dev = 0, cus = 0, per_cu = 0;
        if (hipGetDevice(&dev) != hipSuccess || hipDeviceGetAttribute(&cus, hipDeviceAttributeMultiprocessorCount, dev) != hipSuccess) { grid = -1; return; }
        if (hipFuncSetAttribute((const void*)fwd_kernel, hipFuncAttributeMaxDynamicSharedMemorySize, LDS_BYTES) != hipSuccess) { fprintf(stderr, "kernel_launch: hipFuncSetAttribute failed\n"); grid = -1; return; }
        if (hipOccupancyMaxActiveBlocksPerMultiprocessor(&per_cu, (const void*)fwd_kernel, 512, LDS_BYTES) != hipSuccess || per_cu < 1) { fprintf(stderr, "kernel_launch: occupancy query says %d\n", per_cu); (void)hipGetLastError(); per_cu = 1; }
        grid = cus;
    }
    if (grid < 0) return;
    (void)hipMemsetAsync((char*)d_ws + WS_CTL, 0, CTL_ZERO_BYTES, stream);
    Params p{};
    for (int i = 0; i < 27; ++i) p.in[i] = (const float*)d_in[i];
    p.out = (float*)d_out; p.ws = (unsigned char*)d_ws;
    if (N_LAUNCHES == 1) {
        p.ph_lo = 0; p.ph_hi = NPHASE;
        hipLaunchKernelGGL(fwd_kernel, dim3(grid), dim3(512), LDS_BYTES, stream, p);
    } else {
        for (int k = 0; k < NPHASE + (DBG_SAN ? 1 : 0); ++k) { p.ph_lo = k; p.ph_hi = k + 1; hipLaunchKernelGGL(fwd_kernel, dim3(grid), dim3(512), LDS_BYTES, stream, p); }
    }
}
```

```cpp
#include <hip/hip_runtime.h>
#include <stdint.h>
#include <stdio.h>

#ifndef N_LAUNCHES
#define N_LAUNCHES 1
#endif
#ifndef MQ_MODE
#define MQ_MODE 2
#endif
#ifndef PQ_MODE
#define PQ_MODE 2
#endif
#ifndef WO_MODE
#define WO_MODE 2
#endif

#define LAS __attribute__((address_space(3)))
typedef unsigned short bf16_t;
typedef short bf16x8 __attribute__((ext_vector_type(8)));
typedef short s16x4 __attribute__((ext_vector_type(4)));
typedef float f32x2 __attribute__((ext_vector_type(2)));
typedef float f32x4 __attribute__((ext_vector_type(4)));
typedef float f32x16 __attribute__((ext_vector_type(16)));
typedef unsigned u32x2 __attribute__((ext_vector_type(2)));
typedef unsigned u32x4 __attribute__((ext_vector_type(4)));
typedef int i32x4_t __attribute__((ext_vector_type(4)));

constexpr int NB = 4, SEQ = 4096, DM = 4096, NTOK = NB * SEQ;
constexpr int IN_COLS = 14336, NSLAB = IN_COLS / 128;
constexpr size_t SLAB = (size_t)NTOK * 128;
constexpr int MEM_LEN = 256, NMEM = NB * MEM_LEN;
constexpr int NEXP = 16384;
constexpr float EPS = 1e-6f;
#ifndef TAB_BITS
#define TAB_BITS 4
#endif
constexpr float U_SCALE = TAB_BITS == 8 ? 512.f : 128.f, V_SCALE = TAB_BITS == 8 ? 16.f : 4.f;
constexpr int TAB_ROW = DM * TAB_BITS / 8;
constexpr float H_SCALE = 8.f, XG_SCALE = 4.f, W_SCALE = 512.f;
constexpr float MIX_I8 = 127.f / 8.f;
constexpr float H_I8 = 127.f / 6.f, XG_I8 = 127.f / 8.f, W_I8 = 127.f * 64.f / 5.5f;

constexpr int SL_DQ = 0, SL_DK = 16, SL_DV = 32, SL_GQ = 48, SL_GF = 64, SL_GI = 80, SL_GG = 96;

constexpr size_t WS_CTL    = 0;
constexpr size_t WS_ROWSS1 = 16384;
constexpr size_t WS_ROWSS2 = WS_ROWSS1 + 131072;
constexpr size_t CTL_ZERO_BYTES = WS_ROWSS2 + 131072;
constexpr size_t WS_WIN   = 1u << 20;
constexpr size_t WS_WIN8  = WS_WIN  + (size_t)8192 * DM * 2;
constexpr size_t WS_WIN8E = WS_WIN  + (size_t)6144 * DM * 2;
constexpr size_t WS_WIN8D = WS_WIN  + (size_t)12288 * DM * 2;
constexpr size_t WS_WIN8C = WS_WIN  + (size_t)2048 * DM * 2;
constexpr size_t WS_WIN8B = WS_WIN  + (size_t)10240 * DM * 2;
constexpr size_t WS_WOUT  = WS_WIN  + (size_t)IN_COLS * DM * 2;
constexpr size_t WS_WMQ   = WS_WOUT + (size_t)DM * DM * 2;
constexpr size_t WS_WMKV  = WS_WMQ  + (size_t)512 * DM * 2;
constexpr size_t WS_WMO   = WS_WMKV + (size_t)1024 * DM * 2;
constexpr size_t WS_WPQ   = WS_WMO  + (size_t)DM * 512 * 2;
constexpr size_t WS_KEYS  = WS_WPQ  + (size_t)2048 * DM * 2;
constexpr size_t WS_MEMN  = WS_KEYS + (size_t)8 * 2 * 128 * 128 * 2;
constexpr size_t WS_MEMKV = WS_MEMN + (size_t)NMEM * DM * 2;
constexpr size_t WS_A     = WS_MEMKV + (size_t)8 * NMEM * 128 * 2;
constexpr size_t WS_P     = WS_A + (size_t)NTOK * DM * 2;
constexpr size_t WS_HGO   = WS_P + (size_t)NSLAB * SLAB * 2;
constexpr size_t WS_QMEM  = WS_HGO + (size_t)NTOK * 2048 * 2;
constexpr size_t WS_OMEM  = WS_QMEM + (size_t)4 * SLAB * 2;
constexpr size_t WS_EXP   = WS_OMEM + (size_t)NTOK * 512 * 2;
constexpr size_t WS_GATE  = WS_EXP + (size_t)NTOK * 128 * 4;
constexpr size_t WS_END   = WS_GATE + (size_t)NTOK * 128 * 4;

constexpr int LDS_BYTES = 147456;
constexpr int KN_LDS = 133120;
constexpr int LDS_MISC = 131072;

__device__ __forceinline__ float bf2f(unsigned short b) { return __uint_as_float(((unsigned)b) << 16); }
typedef __bf16 bf16x2_t __attribute__((ext_vector_type(2)));
__device__ __forceinline__ void bf8_f32(const u32x4 r, f32x4& lo, f32x4& hi) {
    lo = (f32x4){__uint_as_float(r.x << 16), __uint_as_float(r.x & 0xffff0000u), __uint_as_float(r.y << 16), __uint_as_float(r.y & 0xffff0000u)};
    hi = (f32x4){__uint_as_float(r.z << 16), __uint_as_float(r.z & 0xffff0000u), __uint_as_float(r.w << 16), __uint_as_float(r.w & 0xffff0000u)}; }
__device__ __forceinline__ unsigned cvtpk(float lo, float hi) { const bf16x2_t r = __builtin_convertvector((f32x2){lo, hi}, bf16x2_t); return __builtin_bit_cast(unsigned, r); }
__device__ __forceinline__ unsigned short f2bf(float x) { return (unsigned short)(cvtpk(x, x) & 0xffffu); }
#define DPPF(x, ctrl) __int_as_float(__builtin_amdgcn_update_dpp(0, __float_as_int(x), (ctrl), 0xF, 0xF, true))
__device__ __forceinline__ float row16_allsum(float x) { x += DPPF(x, 0xB1); x += DPPF(x, 0x4E); x += DPPF(x, 0x141); x += DPPF(x, 0x140); return x; }
__device__ __forceinline__ float rdlane(float x, int l) { return __int_as_float(__builtin_amdgcn_readlane(__float_as_int(x), l)); }
__device__ __forceinline__ float wave_allsum(float x) { x = row16_allsum(x); return (rdlane(x, 0) + rdlane(x, 16)) + (rdlane(x, 32) + rdlane(x, 48)); }
__device__ __forceinline__ float half_allsum(float x) { x = row16_allsum(x); return x + __shfl_xor(x, 16); }
__device__ __forceinline__ float rowscale(const unsigned long long* rowss, int row) { return __builtin_amdgcn_rsqf((float)rowss[row] * (1.0f / 4294967296.0f) * (1.0f / DM) + EPS); }
__device__ __forceinline__ unsigned pk4_fp8(float a, float b, float c, float d) { int t = __builtin_amdgcn_cvt_pk_fp8_f32(a, b, 0, false); t = __builtin_amdgcn_cvt_pk_fp8_f32(c, d, t, true); return (unsigned)t; }
__device__ __forceinline__ unsigned pk4_i8(float a, float b, float c, float d) {
    const int ia = (int)__builtin_rintf(__builtin_amdgcn_fmed3f(a, -127.f, 127.f)), ib = (int)__builtin_rintf(__builtin_amdgcn_fmed3f(b, -127.f, 127.f));
    const int ic = (int)__builtin_rintf(__builtin_amdgcn_fmed3f(c, -127.f, 127.f)), id = (int)__builtin_rintf(__builtin_amdgcn_fmed3f(d, -127.f, 127.f));
    return (unsigned)(ia & 0xff) | ((unsigned)(ib & 0xff) << 8) | ((unsigned)(ic & 0xff) << 16) | ((unsigned)(id & 0xff) << 24);
}
template <int MODE> __device__ __forceinline__ unsigned pk4_q(float a, float b, float c, float d) { if constexpr (MODE == 2) return pk4_i8(a, b, c, d); else return pk4_fp8(a, b, c, d); }
__device__ __forceinline__ float sigmoidf_(float x) { return __builtin_amdgcn_rcpf(1.f + __builtin_amdgcn_exp2f(-1.4426950408889634f * x)); }

#define XB_TMO      128
#define XB_XCNT(j)  (256  + 64 * (j))
#define XB_XSUB(j)  (1280 + 64 * (j))
#define XB_XGEN(j)  (2304 + 64 * (j))
#define XB_TOP      3328
#define XB_TOPGEN   3392
#define XCD_BAR_WORDS 3456
#define XB_SPIN_CAP (1u << 20)
__device__ __forceinline__ unsigned xb_ld(unsigned* p)              { return __hip_atomic_load(p, __ATOMIC_RELAXED, __HIP_MEMORY_SCOPE_AGENT); }
__device__ __forceinline__ unsigned xb_add(unsigned* p, unsigned v) { return __hip_atomic_fetch_add(p, v, __ATOMIC_RELAXED, __HIP_MEMORY_SCOPE_AGENT); }
__device__ __forceinline__ unsigned xb_xcc_id() { return (unsigned)__builtin_amdgcn_s_getreg((3 << 11) | 20) & 0xFu; }
#define XB_SPIN(cond, bar) do { unsigned _sp = 0; while (cond) { __builtin_amdgcn_s_sleep(1); \
    if ((++_sp & 255u) == 0u) { if (xb_ld(&(bar)[XB_TMO])) break; if (_sp > XB_SPIN_CAP) { atomicAdd(&(bar)[XB_TMO], 1u); break; } } } } while (0)
struct XcdBarrier { unsigned* bar; unsigned x; volatile LAS unsigned* st; };
__device__ __forceinline__ XcdBarrier xcd_barrier_post(unsigned* bar, volatile LAS unsigned* st) {
    XcdBarrier b; b.bar = bar; b.x = xb_xcc_id(); b.st = st;
    if (threadIdx.x == 0) (void)xb_add(&bar[XB_XCNT(b.x)], 1u);
    return b;
}
__device__ __forceinline__ void xcd_barrier_complete(unsigned* bar, unsigned x, unsigned& nloc, unsigned& nx) {
    const unsigned G = gridDim.x * gridDim.y * gridDim.z;
    unsigned sum, cnt, mine, sp = 0u;
    for (;;) {
        sum = 0u; cnt = 0u; mine = 0u;
#pragma unroll
        for (unsigned j = 0; j < 16; ++j) { const unsigned c = xb_ld(&bar[XB_XCNT(j)]); sum += c; cnt += (c > 0u) ? 1u : 0u; mine = (j == x) ? c : mine; }
        if (sum == G) break;
        __builtin_amdgcn_s_sleep(1);
        if ((++sp & 255u) == 0u) { if (xb_ld(&bar[XB_TMO])) break; if (sp > XB_SPIN_CAP) { atomicAdd(&bar[XB_TMO], 1u); break; } }
    }
    nloc = mine > 0u ? mine : 1u; nx = cnt > 0u ? cnt : 1u;
}
__device__ __forceinline__ void xcd_barrier(const XcdBarrier& b) {
    asm volatile("s_waitcnt vmcnt(0)" ::: "memory");
    __syncthreads();
    if (threadIdx.x == 0) {
        unsigned* bar = b.bar;
        __builtin_amdgcn_s_waitcnt(0);
        unsigned nloc = b.st[0], nx = b.st[1];
        if (nloc == 0u) { xcd_barrier_complete(bar, b.x, nloc, nx); b.st[0] = nloc; b.st[1] = nx; }
        const unsigned old = xb_add(&bar[XB_XSUB(b.x)], 1u);
        const unsigned gen = old / nloc;
        if (old + 1u == (gen + 1u) * nloc) {
            __builtin_amdgcn_fence(__ATOMIC_RELEASE, "agent");
            asm volatile("s_waitcnt vmcnt(0)" ::: "memory");
            const unsigned og = xb_add(&bar[XB_TOP], 1u);
            const unsigned tg = og / nx;
            if (og + 1u == (tg + 1u) * nx) xb_add(&bar[XB_TOPGEN], 1u);
            else XB_SPIN(xb_ld(&bar[XB_TOPGEN]) == tg, bar);
            __builtin_amdgcn_fence(__ATOMIC_ACQUIRE, "agent");
            xb_add(&bar[XB_XGEN(b.x)], 1u);
            asm volatile("s_waitcnt vmcnt(0)" ::: "memory");
        } else {
            XB_SPIN(xb_ld(&bar[XB_XGEN(b.x)]) == gen, bar);
            __builtin_amdgcn_fence(__ATOMIC_ACQUIRE, "agent");
            asm volatile("s_waitcnt vmcnt(0)" ::: "memory");
        }
    }
    __syncthreads();
}

namespace pg8 {
constexpr int BM = 256, BK = 64, HALF = 128, HTB = HALF * BK * 2, STAGE_BYTES = 8 * HTB, NXCD = 8, WGM = 8;
__device__ __forceinline__ int lds_byte(int r, int c) { const int st = (r >> 4) * 2 + (c >> 5), rr = r & 15, cc = c & 31, ob = rr * 64 + cc * 2; return st * 1024 + (ob ^ (((ob >> 9) & 1) << 5)); }
__device__ __forceinline__ void stage_rc(int b, int& R, int& C) { const int st = b / 1024, sb = b % 1024, swz = sb ^ (((sb >> 9) & 1) << 5); R = (st >> 1) * 16 + swz / 64; C = (st & 1) * 32 + (swz % 64) / 2; }
__device__ __forceinline__ int perm32(int rho) { const int n = rho >> 4, i = rho & 15; return 8 * (i >> 2) + 4 * n + (i & 3); }
struct Unit { int pm, pn; };
struct Gemm { const void* A; const void* Bt; int M, N, K, lda, ldb; };
struct StaticOrder {
    int nM, nN, nwg, G, c;
    __device__ void init(int M, int N, int G_, int c_) { nM = M / BM; nN = N / BM; nwg = nM * nN; G = G_; c = c_; }
    __device__ bool next(int i, Unit& u) const {
        const long L = (long)i * G + c; if (L >= nwg) return false;
        int wgid = (int)L; { const int q = nwg / NXCD, r = nwg % NXCD, xcd = wgid % NXCD, off = wgid / NXCD; wgid = (xcd < r ? xcd * (q + 1) : r * (q + 1) + (xcd - r) * q) + off; }
        const int nig = WGM * nN, gid = wgid / nig, fm = gid * WGM, gsz = (nM - fm) < WGM ? (nM - fm) : WGM;
        u.pm = fm + ((wgid % nig) % gsz); u.pn = (wgid % nig) / gsz; return true;
    }
};
typedef int i32x8 __attribute__((ext_vector_type(8)));
__device__ __forceinline__ i32x8 cat8(bf16x8 a, bf16x8 b) { const u32x4 x = __builtin_bit_cast(u32x4, a), y = __builtin_bit_cast(u32x4, b); return (i32x8){(int)x[0], (int)x[1], (int)x[2], (int)x[3], (int)y[0], (int)y[1], (int)y[2], (int)y[3]}; }
typedef int i32x4v __attribute__((ext_vector_type(4)));
template <class Epi, int F8>
__device__ __forceinline__ void gemm_phase(LAS unsigned char* lds, const Gemm g, const StaticOrder& S, const Epi& E) {
    const int tid = threadIdx.x, wid = __builtin_amdgcn_readfirstlane(tid >> 6), lane = tid & 63, wr = wid >> 2, wc = wid & 3, fr = lane & 15, fq = lane >> 4;
    const int K = g.K, nt = K / (F8 != 0 ? 2 * BK : BK);
    unsigned voffA[2], voffB[2];
#pragma unroll
    for (int i = 0; i < 2; ++i) { int R, C; stage_rc(tid * 16 + i * 8192, R, C); const int Rb = (R & ~31) + perm32(R & 31);
        voffA[i] = (unsigned)(R * g.lda + C * 2); voffB[i] = (unsigned)(Rb * g.ldb + C * 2); }
    const size_t kstep = (size_t)(BK * 2);
    const size_t hstepA = (size_t)HALF * g.lda, hstepB = (size_t)HALF * g.ldb;
    const size_t tstepA = 2 * hstepA, tstepB = 2 * hstepB;
    const unsigned ldsw = (unsigned)wid * 1024u;
    const int aoff = lds_byte(wr * 64 + fr, fq * 8), boff = lds_byte(wc * 32 + fr, fq * 8);
#define PG8_SA(b, h) (((b) * 2 + (h)) * HTB)
#define PG8_SB(b, h) ((4 + (b) * 2 + (h)) * HTB)
#define PG8_STAGE(bufoff, gbase, voff) do { _Pragma("unroll") for (int _i = 0; _i < 2; ++_i) \
        __builtin_amdgcn_global_load_lds((const unsigned*)((const char*)(gbase) + (voff)[_i]), (LAS unsigned*)(lds + (bufoff) + ldsw + _i * 8192), 16, 0, 0); } while (0)
#define PG8_LDA(dst, b, h) do { _Pragma("unroll") for (int m = 0; m < 4; ++m) _Pragma("unroll") for (int k = 0; k < 2; ++k) dst[m][k] = *(const LAS bf16x8*)(lds + PG8_SA(b, h) + aoff + m * 2048 + k * 1024); } while (0)
#define PG8_LDB(dst, b, h) do { _Pragma("unroll") for (int n = 0; n < 2; ++n) _Pragma("unroll") for (int k = 0; k < 2; ++k) dst[n][k] = *(const LAS bf16x8*)(lds + PG8_SB(b, h) + boff + n * 2048 + k * 1024); } while (0)
#define PG8_MMA(ai, bj, At, Bt) do { __builtin_amdgcn_s_setprio(1); _Pragma("unroll") for (int m = 0; m < 4; ++m) _Pragma("unroll") for (int n = 0; n < 2; ++n) { \
        if constexpr (F8 == 1) { const i32x8 b8_ = cat8(Bt[n][0], Bt[n][1]), a8_ = cat8(At[m][0], At[m][1]); \
            asm volatile("v_mfma_scale_f32_16x16x128_f8f6f4 %0, %1, %2, %0, %3, %3 op_sel_hi:[0,0,0]" : "+v"(acc[ai][bj][m][n]) : "v"(b8_), "v"(a8_), "v"(sc127)); } \
        else if constexpr (F8 == 2) { _Pragma("unroll") for (int k = 0; k < 2; ++k) acc[ai][bj][m][n] = __builtin_bit_cast(f32x4, __builtin_amdgcn_mfma_i32_16x16x64_i8(__builtin_bit_cast(i32x4v, Bt[n][k]), __builtin_bit_cast(i32x4v, At[m][k]), __builtin_bit_cast(i32x4v, acc[ai][bj][m][n]), 0, 0, 0)); } \
        else { _Pragma("unroll") for (int k = 0; k < 2; ++k) acc[ai][bj][m][n] = __builtin_amdgcn_mfma_f32_16x16x32_bf16(Bt[n][k], At[m][k], acc[ai][bj][m][n], 0, 0, 0); } } __builtin_amdgcn_s_setprio(0); } while (0)
#define PG8_WAIT_V(n) asm volatile("s_waitcnt vmcnt(" #n ")" ::: "memory")
#define PG8_WAIT_L(n) asm volatile("s_waitcnt lgkmcnt(" #n ")" ::: "memory")
#define PG8_BAR __builtin_amdgcn_s_barrier()
#define PG8_SCHED __builtin_amdgcn_sched_barrier(0)
    Unit cur, nxt; int ui = 0;
    if (!S.next(0, cur)) return;
    int sc127 = 127; asm volatile("" : "+v"(sc127));
    f32x4 acc[2][2][4][2];
#pragma unroll
    for (int a = 0; a < 2; ++a)
#pragma unroll
        for (int b = 0; b < 2; ++b)
#pragma unroll
            for (int m = 0; m < 4; ++m)
#pragma unroll
                for (int n = 0; n < 2; ++n) acc[a][b][m][n] = (f32x4){0.f, 0.f, 0.f, 0.f};
    bf16x8 At[4][2], B0[2][2], B1[2][2];
    const char* cA = (const char*)g.A + (size_t)cur.pm * tstepA; const char* cB = (const char*)g.Bt + (size_t)cur.pn * tstepB;
    PG8_STAGE(PG8_SB(0, 0), cB, voffB); PG8_STAGE(PG8_SA(0, 0), cA, voffA); PG8_STAGE(PG8_SB(0, 1), cB + hstepB, voffB); PG8_STAGE(PG8_SA(0, 1), cA + hstepA, voffA);
    if (wr == 1) PG8_BAR;
    PG8_WAIT_V(4); PG8_BAR;
    PG8_STAGE(PG8_SB(1, 0), cB + kstep, voffB); PG8_STAGE(PG8_SA(1, 0), cA + kstep, voffA); PG8_STAGE(PG8_SB(1, 1), cB + hstepB + kstep, voffB);
    PG8_WAIT_V(6); PG8_BAR;
    for (;;) {
        const bool has_next = S.next(ui + 1, nxt);
        const char* nA = has_next ? (const char*)g.A + (size_t)nxt.pm * tstepA : cA; const char* nB = has_next ? (const char*)g.Bt + (size_t)nxt.pn * tstepB : cB;
        for (int t = 0; t < nt; t += 2) {
            const bool last = (t == nt - 2);
            const char* a1 = cA + (size_t)(t + 1) * kstep;
            const char* a2 = last ? nA : cA + (size_t)(t + 2) * kstep; const char* b2 = last ? nB : cB + (size_t)(t + 2) * kstep;
            const char* a3 = a2 + kstep; const char* b3 = b2 + kstep;
            PG8_LDB(B0, 0, 0); PG8_SCHED; PG8_LDA(At, 0, 0); PG8_STAGE(PG8_SA(1, 1), a1 + hstepA, voffA);
            PG8_WAIT_L(8); PG8_BAR; PG8_WAIT_L(0); PG8_MMA(0, 0, At, B0); PG8_BAR; PG8_SCHED;
            PG8_LDB(B1, 0, 1); PG8_STAGE(PG8_SB(0, 0), b2, voffB);
            PG8_BAR; PG8_WAIT_L(0); PG8_MMA(0, 1, At, B1); PG8_BAR;
            PG8_LDA(At, 0, 1); PG8_STAGE(PG8_SA(0, 0), a2, voffA);
            PG8_BAR; PG8_WAIT_L(0); PG8_MMA(1, 0, At, B0); PG8_BAR; PG8_SCHED;
            PG8_STAGE(PG8_SB(0, 1), b2 + hstepB, voffB);
            PG8_WAIT_V(6); PG8_BAR; PG8_MMA(1, 1, At, B1); PG8_BAR;
            PG8_LDB(B0, 1, 0); PG8_SCHED; PG8_LDA(At, 1, 0); PG8_STAGE(PG8_SA(0, 1), a2 + hstepA, voffA);
            PG8_WAIT_L(8); PG8_BAR; PG8_WAIT_L(0); PG8_MMA(0, 0, At, B0); PG8_BAR; PG8_SCHED;
            PG8_LDB(B1, 1, 1); PG8_STAGE(PG8_SB(1, 0), b3, voffB);
            PG8_BAR; PG8_WAIT_L(0); PG8_MMA(0, 1, At, B1); PG8_BAR;
            PG8_LDA(At, 1, 1); PG8_STAGE(PG8_SA(1, 0), a3, voffA);
            PG8_BAR; PG8_WAIT_L(0); PG8_MMA(1, 0, At, B0); PG8_BAR; PG8_SCHED;
            PG8_STAGE(PG8_SB(1, 1), b3 + hstepB, voffB);
            PG8_WAIT_V(6); PG8_BAR; PG8_MMA(1, 1, At, B1); PG8_BAR;
        }
        if constexpr (F8 == 2) {
#pragma unroll
            for (int a = 0; a < 2; ++a)
#pragma unroll
                for (int b = 0; b < 2; ++b)
#pragma unroll
                    for (int m = 0; m < 4; ++m)
#pragma unroll
                        for (int n = 0; n < 2; ++n) { const i32x4v iv = __builtin_bit_cast(i32x4v, acc[a][b][m][n]); acc[a][b][m][n] = (f32x4){(float)iv[0], (float)iv[1], (float)iv[2], (float)iv[3]}; }
        }
        if constexpr (F8 == 1) asm volatile("s_nop 15\n\ts_nop 7" ::: "memory");
        E(acc, cur, wr, wc, fr, fq);
        if (!has_next) break;
#pragma unroll
        for (int a = 0; a < 2; ++a)
#pragma unroll
            for (int b = 0; b < 2; ++b)
#pragma unroll
                for (int m = 0; m < 4; ++m)
#pragma unroll
                    for (int n = 0; n < 2; ++n) acc[a][b][m][n] = (f32x4){0.f, 0.f, 0.f, 0.f};
        cur = nxt; cA = nA; cB = nB; ++ui;
    }
    PG8_WAIT_V(0);
    if (wr == 0) PG8_BAR;
    PG8_BAR;
#undef PG8_SA
#undef PG8_SB
#undef PG8_STAGE
#undef PG8_LDA
#undef PG8_LDB
#undef PG8_MMA
#undef PG8_WAIT_V
#undef PG8_WAIT_L
#undef PG8_BAR
#undef PG8_SCHED
}

struct EpiBf16S {
    bf16_t* O; const unsigned long long* rowss; int slab; size_t slab_stride; int ldc; float descale; int sl_split, sl_d0, sl_d1;
    const float* kn_gain; int kn_lo, kn_hi; LAS float* kn_lds;
    __device__ __forceinline__ void operator()(const f32x4 (&acc)[2][2][4][2], const Unit& u, int wr, int wc, int fr, int fq) const {
        const int row0 = u.pm * BM + wr * 64 + fr;
        const bool kn = kn_gain != nullptr && u.pn * 2 >= kn_lo && u.pn * 2 < kn_hi;
        float rsn[2][4][2]; f32x4 kg0 = {1.f, 1.f, 1.f, 1.f}, kg1 = {1.f, 1.f, 1.f, 1.f};
        if (kn) {
            kg0 = *(const f32x4*)(kn_gain + wc * 32 + 8 * fq); kg1 = *(const f32x4*)(kn_gain + wc * 32 + 8 * fq + 4);
#pragma unroll
            for (int ai = 0; ai < 2; ++ai)
#pragma unroll
                for (int m = 0; m < 4; ++m)
#pragma unroll
                    for (int bj = 0; bj < 2; ++bj) {
                        const f32x4 v0 = acc[ai][bj][m][0], v1 = acc[ai][bj][m][1];
                        float ss = (v0[0] * v0[0] + v0[1] * v0[1]) + (v0[2] * v0[2] + v0[3] * v0[3]) + (v1[0] * v1[0] + v1[1] * v1[1]) + (v1[2] * v1[2] + v1[3] * v1[3]);
                        ss += __shfl_xor(ss, 16); ss += __shfl_xor(ss, 32);
                        if (fq == 0) kn_lds[((wr * 64 + fr + ai * HALF + m * 16) * 2 + bj) * 4 + wc] = ss;
                    }
            asm volatile("s_waitcnt lgkmcnt(0)\n\ts_barrier" ::: "memory");
#pragma unroll
            for (int ai = 0; ai < 2; ++ai)
#pragma unroll
                for (int m = 0; m < 4; ++m)
#pragma unroll
                    for (int bj = 0; bj < 2; ++bj) {
                        const f32x4 t = *(const LAS f32x4*)(kn_lds + ((wr * 64 + fr + ai * HALF + m * 16) * 2 + bj) * 4);
                        rsn[ai][m][bj] = __builtin_amdgcn_rsqf(((t[0] + t[1]) + (t[2] + t[3])) * (descale * descale) * (1.0f / 128.0f) + EPS);
                    }
        }
        float rsc[2][4];
#pragma unroll
        for (int ai = 0; ai < 2; ++ai)
#pragma unroll
            for (int m = 0; m < 4; ++m) rsc[ai][m] = rowss ? descale * rowscale(rowss, row0 + ai * HALF + m * 16) : descale;
        __builtin_amdgcn_sched_barrier(0);
#pragma unroll
        for (int ai = 0; ai < 2; ++ai)
#pragma unroll
            for (int m = 0; m < 4; ++m) {
                const int row = row0 + ai * HALF + m * 16;
                const float sc = rsc[ai][m];
#pragma unroll
                for (int bj = 0; bj < 2; ++bj) {
                    f32x4 v0 = acc[ai][bj][m][0] * sc, v1 = acc[ai][bj][m][1] * sc;
                    if (kn) { v0 = v0 * rsn[ai][m][bj] * kg0; v1 = v1 * rsn[ai][m][bj] * kg1; }
                    u32x4 w; w.x = cvtpk(v0[0], v0[1]); w.y = cvtpk(v0[2], v0[3]); w.z = cvtpk(v1[0], v1[1]); w.w = cvtpk(v1[2], v1[3]);
                    const int sl_ = u.pn * 2 + bj;
                    bf16_t* p = slab ? O + (size_t)(sl_ + (sl_ < sl_split ? sl_d0 : sl_d1)) * slab_stride + (size_t)row * 128 + wc * 32 + 8 * fq
                                     : O + (size_t)row * ldc + u.pn * BM + bj * HALF + wc * 32 + 8 * fq;
                    *(u32x4*)p = w; }
            }
    }
};
template <int G8, bool BASE_BF16> struct EpiResid {
    const void* base; bf16_t* out; void* outg; const float* gain; unsigned long long* rowss; float descale;
    __device__ __forceinline__ void operator()(const f32x4 (&acc)[2][2][4][2], const Unit& u, int wr, int wc, int fr, int fq) const {
        const int row0 = u.pm * BM + wr * 64 + fr, col0 = u.pn * BM + wc * 32 + 8 * fq;
        f32x4 gv[2][2];
        if constexpr (G8 > 0) {
#pragma unroll
            for (int bj = 0; bj < 2; ++bj)
#pragma unroll
                for (int n = 0; n < 2; ++n) gv[bj][n] = *(const f32x4*)(gain + col0 + bj * HALF + 4 * n);
        }
        f32x4 val[2][2][4][2]; float ssr[2][4];
#pragma unroll
        for (int ai = 0; ai < 2; ++ai)
#pragma unroll
            for (int m = 0; m < 4; ++m) {
                const int row = row0 + ai * HALF + m * 16; float ss = 0.f;
#pragma unroll
                for (int bj = 0; bj < 2; ++bj) {
                    const size_t off = (size_t)row * DM + col0 + bj * HALF;
                    f32x4 b0, b1;
                    if constexpr (BASE_BF16) bf8_f32(*(const u32x4*)((const bf16_t*)base + off), b0, b1);
                    else { b0 = *(const f32x4*)((const float*)base + off); b1 = *(const f32x4*)((const float*)base + off + 4); }
                    const f32x4 v0 = acc[ai][bj][m][0] * descale + b0, v1 = acc[ai][bj][m][1] * descale + b1;
                    val[ai][bj][m][0] = v0; val[ai][bj][m][1] = v1;
                    ss += (v0[0] * v0[0] + v0[1] * v0[1]) + (v0[2] * v0[2] + v0[3] * v0[3]) + (v1[0] * v1[0] + v1[1] * v1[1]) + (v1[2] * v1[2] + v1[3] * v1[3]); }
                ss += __shfl_xor(ss, 16); ss += __shfl_xor(ss, 32);
                ssr[ai][m] = ss;
                if (m == 3) __builtin_amdgcn_sched_barrier(0);
            }
        __builtin_amdgcn_sched_barrier(0);
#pragma unroll
        for (int ai = 0; ai < 2; ++ai)
#pragma unroll
            for (int m = 0; m < 4; ++m) {
                const int row = row0 + ai * HALF + m * 16;
#pragma unroll
                for (int bj = 0; bj < 2; ++bj) {
                    const size_t off = (size_t)row * DM + col0 + bj * HALF;
                    const f32x4 v0 = val[ai][bj][m][0], v1 = val[ai][bj][m][1];
                    { u32x4 w; w.x = cvtpk(v0[0], v0[1]); w.y = cvtpk(v0[2], v0[3]); w.z = cvtpk(v1[0], v1[1]); w.w = cvtpk(v1[2], v1[3]); *(u32x4*)(out + off) = w; }
                    if constexpr (G8 > 0) { constexpr float GS = G8 == 2 ? XG_I8 : XG_SCALE; const f32x4 g0 = v0 * gv[bj][0] * GS, g1 = v1 * gv[bj][1] * GS;
                        u32x2 w; w.x = pk4_q<G8>(g0[0], g0[1], g0[2], g0[3]); w.y = pk4_q<G8>(g1[0], g1[1], g1[2], g1[3]);
                        *(u32x2*)((unsigned char*)outg + off) = w; } }
                if (fq == 0) atomicAdd(rowss + row, (unsigned long long)(ssr[ai][m] * 4294967296.0f));
            }
    }
};
}

namespace att {
constexpr int D = 128, NW = 8, QBLK = 32, KVBLK = 64, QB = NW * QBLK;
constexpr int SHM_V = KVBLK * D * 2, SHM_K = KVBLK * D * 2;
constexpr int ATT_LDS = 2 * SHM_V + 2 * SHM_K + NW * 64 * 4;
constexpr float SCALE = 0.08838834764831845f, THR = 8.f;
#define KSWZ(row, colB) ((row) * 256 + ((colB) ^ (((row) & 7) << 4)))
#define SBAR() __builtin_amdgcn_sched_barrier(0)
__device__ __forceinline__ int v_st(int k, int c) { const int kk = (k & ~0xC) | ((k & 4) << 1) | ((k & 8) >> 1); return ((kk >> 3) * 4 + (c >> 5)) * 512 + ((kk & 7) * 32 + (c & 31)) * 2; }
__device__ __forceinline__ int v_rd_base(int lane) { return ((lane & 3) << 3) | (((lane >> 2) & 3) << 6) | (((lane >> 4) & 1) << 5) | (((lane >> 5) & 1) << 8); }
constexpr int v_rd_off(int d0, int ks, int half) { return d0 * 512 + ks * 4096 + half * 2048; }
__device__ __forceinline__ int crow(int r, int hi) { return (r & 3) + 8 * (r >> 2) + 4 * hi; }
__device__ __forceinline__ bf16x8 load8(const bf16_t* p) { return *reinterpret_cast<const bf16x8*>(p); }
__device__ __forceinline__ void mask_tile(f32x16& p0, f32x16& p1, int dq) {
    const float NEG = -__builtin_inff();
#pragma unroll
    for (int r = 0; r < 16; ++r) {
        const int c = (r & 3) + 8 * (r >> 2);
        if (dq - c < 0) p0[r] = NEG;
        if (dq - c - 32 < 0) p1[r] = NEG;
    }
}
__device__ __forceinline__ void partialSM(f32x16& p0, f32x16& p1, float& m_reg, float& mn, float& alpha, bool masked) {
    float pmax = p0[0]; for (int r = 1; r < 16; ++r) pmax = fmaxf(pmax, p0[r]); for (int r = 0; r < 16; ++r) pmax = fmaxf(pmax, p1[r]);
    { auto rr = __builtin_amdgcn_permlane32_swap(__float_as_uint(pmax), __float_as_uint(pmax), false, false);
      pmax = fmaxf(__uint_as_float(rr[0]), __uint_as_float(rr[1])); }
    if (masked) pmax = -__builtin_inff();
    constexpr float C2 = 1.4426950408889634f * SCALE;
    if (__builtin_expect(__all((pmax - m_reg) * SCALE <= THR), 1)) { mn = m_reg; alpha = 1.f; }
    else { mn = fmaxf(m_reg, pmax); alpha = __builtin_amdgcn_exp2f((m_reg - mn) * C2); m_reg = mn; }
    const float mnL = masked ? -__builtin_inff() : -mn * C2;
    for (int r = 0; r < 16; ++r) p0[r] = fmaf(p0[r], C2, mnL); for (int r = 0; r < 16; ++r) p1[r] = fmaf(p1[r], C2, mnL);
    for (int r = 0; r < 16; ++r) p0[r] = __builtin_amdgcn_exp2f(p0[r]);
}
__device__ __forceinline__ void finishSM(f32x16& p0, f32x16& p1, float alpha, float& l_reg, bf16x8& pa0, bf16x8& pa1, bf16x8& pa2, bf16x8& pa3) {
    for (int r = 0; r < 16; ++r) p1[r] = __builtin_amdgcn_exp2f(p1[r]);
    float ps = 0; for (int r = 0; r < 16; ++r) ps += p0[r]; for (int r = 0; r < 16; ++r) ps += p1[r];
    { auto rr = __builtin_amdgcn_permlane32_swap(__float_as_uint(ps), __float_as_uint(ps), false, false);
      ps = __uint_as_float(rr[0]) + __uint_as_float(rr[1]); }
    l_reg = l_reg * alpha + ps;
#define PK4(P, B_, OUT) do { unsigned a0 = cvtpk(P[B_+0], P[B_+1]), a1 = cvtpk(P[B_+2], P[B_+3]);                          \
        unsigned b0 = cvtpk(P[B_+4], P[B_+5]), b1 = cvtpk(P[B_+6], P[B_+7]);                                             \
        auto r0 = __builtin_amdgcn_permlane32_swap(a0, b0, false, false); auto r1 = __builtin_amdgcn_permlane32_swap(a1, b1, false, false); \
        u32x4 w = {r0[0], r1[0], r0[1], r1[1]}; OUT = *reinterpret_cast<bf16x8*>(&w); } while (0)
    PK4(p0, 0, pa0); PK4(p0, 8, pa1); PK4(p1, 0, pa2); PK4(p1, 8, pa3);
#undef PK4
}
template <int KB>
__device__ __forceinline__ void qkt(f32x16& p0, f32x16& p1, const char* K_lds, int r32, int hi, const bf16x8* qr) {
    p0 = f32x16{}; p1 = f32x16{};
    const char* kb[4];
#pragma unroll
    for (int dd = 0; dd < 4; ++dd) kb[dd] = K_lds + KB * SHM_K + KSWZ(r32, (dd * 16 + hi * 8) * 2);
#pragma unroll
    for (int d0 = 0; d0 < 8; ++d0) { const char* a = kb[d0 & 3] + (d0 >> 2) * 128;
        bf16x8 b0 = *reinterpret_cast<const bf16x8*>(a);
        bf16x8 b1 = *reinterpret_cast<const bf16x8*>(a + 32 * 256);
        p0 = __builtin_amdgcn_mfma_f32_32x32x16_bf16(b0, qr[d0], p0, 0, 0, 0);
        p1 = __builtin_amdgcn_mfma_f32_32x32x16_bf16(b1, qr[d0], p1, 0, 0, 0); }
}
template <int VB>
__device__ __forceinline__ void pv_tile(f32x16* o, int vb0, bf16x8 pa0, bf16x8 pa1, bf16x8 pa2, bf16x8 pa3) {
#define TRRD(dst, off) asm volatile("ds_read_b64_tr_b16 %0, %1 offset:%2" : "=&v"(dst) : "v"(vb0), "i"(off) : "memory")
#define PV_D0(d0) do { s16x4 l0, l1, l2, l3, h0, h1, h2, h3; constexpr int b_ = VB * SHM_V + v_rd_off(d0, 0, 0); \
        TRRD(l0, b_); TRRD(h0, b_ + 2048); TRRD(l1, b_ + 4096); TRRD(h1, b_ + 6144); TRRD(l2, b_ + 8192); TRRD(h2, b_ + 10240); TRRD(l3, b_ + 12288); TRRD(h3, b_ + 14336); \
        asm volatile("s_waitcnt lgkmcnt(0)" ::: "memory"); SBAR();   \
        o[d0] = __builtin_amdgcn_mfma_f32_32x32x16_bf16(pa0, (bf16x8){l0[0], l0[1], l0[2], l0[3], h0[0], h0[1], h0[2], h0[3]}, o[d0], 0, 0, 0);   \
        o[d0] = __builtin_amdgcn_mfma_f32_32x32x16_bf16(pa1, (bf16x8){l1[0], l1[1], l1[2], l1[3], h1[0], h1[1], h1[2], h1[3]}, o[d0], 0, 0, 0);   \
        o[d0] = __builtin_amdgcn_mfma_f32_32x32x16_bf16(pa2, (bf16x8){l2[0], l2[1], l2[2], l2[3], h2[0], h2[1], h2[2], h2[3]}, o[d0], 0, 0, 0);   \
        o[d0] = __builtin_amdgcn_mfma_f32_32x32x16_bf16(pa3, (bf16x8){l3[0], l3[1], l3[2], l3[3], h3[0], h3[1], h3[2], h3[3]}, o[d0], 0, 0, 0); } while (0)
    PV_D0(0); PV_D0(1); PV_D0(2); PV_D0(3);
#undef PV_D0
#undef TRRD
}
struct BlockRef { const bf16_t* Q; const bf16_t* K; const bf16_t* V; bf16_t* O; int P0; };
struct Seam { bf16x8 qr[8]; bf16x8 st_v0, st_v1, st_k0, st_k1; };
#define ROW(p, k0, rr) ((p) + (size_t)((k0) + (rr)) * D + sc)
#define VMW() asm volatile("s_waitcnt vmcnt(0)" ::: "memory")
#define VMWN(n) asm volatile("s_waitcnt vmcnt(%0)" :: "i"(n) : "memory")
#define SLOAD_H(Kp, Vp, k0) do { S.st_v0 = load8(ROW(Vp, k0, sr)); S.st_v1 = load8(ROW(Vp, k0, 32 + sr));              \
                         S.st_k0 = load8(ROW(Kp, k0, sr)); S.st_k1 = load8(ROW(Kp, k0, 32 + sr)); } while (0)
#define SWRITE_HK(bf) do { *(bf16x8*)(K_lds + (bf) * SHM_K + kws) = S.st_k0; *(bf16x8*)(K_lds + (bf) * SHM_K + kws + 32 * 256) = S.st_k1; } while (0)
#define SWRITE_HV(bf) do { *(bf16x8*)(V_lds + (bf) * SHM_V + vst0) = S.st_v0; *(bf16x8*)(V_lds + (bf) * SHM_V + vst1) = S.st_v1; } while (0)
#define SWRITE_H(bf) do { SWRITE_HV(bf); SWRITE_HK(bf); } while (0)
__device__ __forceinline__ void attn_prime(const BlockRef& cur, char* lds, Seam& S) {
    const int tid = threadIdx.x, wid = __builtin_amdgcn_readfirstlane(tid >> 6), lane = tid & 63, r32 = lane & 31, hi = lane >> 5;
    const int sr = tid >> 4, sc = (tid & 15) * 8, kws = KSWZ(sr, sc * 2); char* K_lds = lds + 2 * SHM_V;
    for (int d0 = 0; d0 < 8; ++d0) S.qr[d0] = load8(cur.Q + (size_t)(wid * QBLK + r32) * D + d0 * 16 + hi * 8);
    SLOAD_H(cur.K, cur.V, 0); VMW(); SWRITE_HK(0);
    __syncthreads();
}
__device__ __forceinline__ void qnorm(bf16x8 (&qr)[8], const float* gain, int hi) {
    float ss = 0.f;
#pragma unroll
    for (int d0 = 0; d0 < 8; ++d0)
#pragma unroll
        for (int j = 0; j < 8; ++j) { const float v = bf2f((unsigned short)qr[d0][j]); ss += v * v; }
    { auto rr = __builtin_amdgcn_permlane32_swap(__float_as_uint(ss), __float_as_uint(ss), false, false); ss = __uint_as_float(rr[0]) + __uint_as_float(rr[1]); }
    const float rs = __builtin_amdgcn_rsqf(ss * (1.0f / 128.0f) + EPS);
#pragma unroll
    for (int d0 = 0; d0 < 8; ++d0) {
        const f32x4 g0 = *(const f32x4*)(gain + d0 * 16 + hi * 8), g1 = *(const f32x4*)(gain + d0 * 16 + hi * 8 + 4);
        float v[8];
#pragma unroll
        for (int j = 0; j < 8; ++j) v[j] = bf2f((unsigned short)qr[d0][j]) * rs;
        u32x4 w; w.x = cvtpk(v[0] * g0[0], v[1] * g0[1]); w.y = cvtpk(v[2] * g0[2], v[3] * g0[3]); w.z = cvtpk(v[4] * g1[0], v[5] * g1[1]); w.w = cvtpk(v[6] * g1[2], v[7] * g1[3]);
        qr[d0] = *reinterpret_cast<bf16x8*>(&w);
    }
}
template <bool CAUSAL>
__device__ __forceinline__ void attn_block(const BlockRef& cur, const BlockRef& nxt, int skv, int ldo, const float* qgain, char* lds, Seam& S) {
    const int tid = threadIdx.x, wid = __builtin_amdgcn_readfirstlane(tid >> 6), lane = tid & 63, r32 = lane & 31, hi = lane >> 5;
    int j_hi = skv / KVBLK; if (CAUSAL) { const int jh = (cur.P0 + QB - 1) / KVBLK + 1; if (jh < j_hi) j_hi = jh; }
    const int NT = j_hi;
    const int qlo = (cur.P0 + wid * QBLK) | 63;
    char* V_lds = lds; char* K_lds = lds + 2 * SHM_V;
    float* ws = (float*)(lds + 2 * SHM_V + 2 * SHM_K) + wid * 64; float* li_l = ws, * al_l = ws + 32;
    float m_reg = -1e30f, l_reg = 0; f32x16 o[4] = {};
    const int sr = tid >> 4, sc = (tid & 15) * 8, vst0 = v_st(sr, sc), vst1 = v_st(32 + sr, sc), kws = KSWZ(sr, sc * 2);
    const int vb0 = (int)(uintptr_t)V_lds + v_rd_base(lane);
    const bf16_t* Kh = cur.K; const bf16_t* Vh = cur.V;
    qnorm(S.qr, qgain, hi);
    if (wid >= 4) __builtin_amdgcn_s_setprio(1);
#define RESC(a) do { if (__any((a) < 1.f)) { if (hi == 0) al_l[r32] = (a); asm volatile("s_waitcnt lgkmcnt(0)" ::: "memory");              \
                     for (int d_ = 0; d_ < 4; ++d_) for (int r = 0; r < 16; ++r) o[d_][r] *= al_l[crow(r, hi)]; } } while (0)
#define KBASE(t) ((t) * KVBLK)
#define MASKT(t) (CAUSAL && KBASE(t) > qlo)
    constexpr int NQL = 8;
#define SEAM_K0() do { VMWN(NQL); SWRITE_HK(0); SBAR(); } while (0)
    f32x16 pA0, pA1, pB0, pB1; float mnA, mnB, alA, alB; bf16x8 pa0, pa1, pa2, pa3;
    SWRITE_HV(0); SBAR();
    if (NT > 1) { SLOAD_H(Kh, Vh, KBASE(1)); }
    SBAR(); qkt<0>(pA0, pA1, K_lds, r32, hi, S.qr);
    partialSM(pA0, pA1, m_reg, mnA, alA, false);
    if (NT > 1) { VMW(); SWRITE_H(1); }
    __syncthreads();
#define HALF_STEP(PX0, PX1, mnX, alX, PY0, PY1, alY, t, KB, VB, SB) do {                                                      \
        SBAR(); if ((t) + 1 < NT) { SLOAD_H(Kh, Vh, KBASE((t) + 1)); SBAR(); }                                       \
        qkt<KB>(PX0, PX1, K_lds, r32, hi, S.qr);                                             \
        finishSM(PY0, PY1, alY, l_reg, pa0, pa1, pa2, pa3); SBAR();                                                           \
        pv_tile<VB>(o, vb0, pa0, pa1, pa2, pa3); partialSM(PX0, PX1, m_reg, mnX, alX, MASKT(t));                                        \
        __syncthreads();                                                                                                      \
        if ((t) + 1 < NT) { VMW(); SWRITE_H(SB); }                                                                          \
        RESC(alX); __syncthreads(); } while (0)
    for (int t = 1; t + 1 < NT; t += 2) {
        HALF_STEP(pB0, pB1, mnB, alB, pA0, pA1, alA, t, 1, 0, 0);
        HALF_STEP(pA0, pA1, mnA, alA, pB0, pB1, alB, t + 1, 0, 1, 1);
    }
    const bool even = (NT & 1) == 0;
    if (even) { SBAR(); qkt<1>(pB0, pB1, K_lds, r32, hi, S.qr); SBAR(); }
    SLOAD_H(nxt.K, nxt.V, 0); SBAR();
#pragma unroll
    for (int d0 = 0; d0 < 8; ++d0) S.qr[d0] = load8(nxt.Q + (size_t)(wid * QBLK + r32) * D + d0 * 16 + hi * 8);
    SBAR();
    finishSM(pA0, pA1, alA, l_reg, pa0, pa1, pa2, pa3); SBAR();
    pv_tile<0>(o, vb0, pa0, pa1, pa2, pa3);
    if (even) { partialSM(pB0, pB1, m_reg, mnB, alB, MASKT(NT - 1)); __syncthreads(); RESC(alB);
        finishSM(pB0, pB1, alB, l_reg, pa0, pa1, pa2, pa3); SBAR(); pv_tile<1>(o, vb0, pa0, pa1, pa2, pa3); }
    SBAR(); SEAM_K0();
    if (hi == 0) li_l[r32] = l_reg; asm volatile("s_waitcnt lgkmcnt(0)" ::: "memory");
    float rli[16];
#pragma unroll
    for (int r = 0; r < 16; ++r) rli[r] = __builtin_amdgcn_rcpf(li_l[crow(r, hi)]);
    bf16_t* Ow = cur.O + (size_t)(wid * QBLK) * ldo;
#pragma unroll
    for (int r = 0; r < 16; ++r) { const int orow = crow(r, hi);
#pragma unroll
        for (int d0 = 0; d0 < 4; ++d0) { const float v = o[d0][r] * rli[r];
            const float vn = __shfl_xor(v, 1);
            if ((r32 & 1) == 0) *(unsigned*)(Ow + (size_t)orow * ldo + d0 * 32 + r32) = cvtpk(v, vn); } }
    __builtin_amdgcn_s_setprio(0);
    __syncthreads();
#undef RESC
#undef KBASE
#undef MASKT
#undef SEAM_K0
#undef HALF_STEP
}
#undef ROW
#undef VMW
#undef VMWN
#undef SLOAD_H
#undef SWRITE_HK
#undef SWRITE_HV
#undef SWRITE_H
}

struct Params { const float* in[27]; float* out; unsigned char* ws; int ph_lo, ph_hi; };
enum { I_X = 0, I_MEM, I_LB, I_MIXN, I_WIN, I_DQN, I_DKN, I_LQ1, I_LK1, I_LQ2, I_LK2, I_SUBLN, I_HGN, I_WOUT, I_MEMN, I_MEMKVN, I_WMQ, I_WMK, I_WMV, I_MQN, I_MKN, I_WMO, I_FFNN, I_PWQ, I_PKEYS, I_PU, I_PV };
constexpr int NPHASE = 12;

template <int F8, bool RG = false>
__device__ __forceinline__ void transpose_cvt(const float* src, int R, int C, int lsrc, void* dstv, int ldd, int row_off, float scale, LAS unsigned char* lds, int wg, int nwg, const float* rgain = nullptr) {
    const int tid = threadIdx.x, ntc = C / 64, ntiles = (R / 64) * ntc;
    const int r = tid >> 3, c8 = (tid & 7) * 8;
    if (wg >= ntiles) return;
    const int nw = (ntiles - wg + nwg - 1) / nwg;
    f32x4 aA, bA, aB, bB; float gA = 1.f, gB = 1.f;
#define TC_TILE(j) (wg + ((j) < nw ? (j) : nw - 1) * nwg)
#define TC_LOAD(a_, b_, g_, j) do { const int t_ = TC_TILE(j); const float* p_ = src + (size_t)((t_ / ntc) * 64 + r) * lsrc + (t_ % ntc) * 64 + c8; a_ = *(const f32x4*)p_; b_ = *(const f32x4*)(p_ + 4); \
        if constexpr (RG) g_ = rgain[(t_ / ntc) * 64 + r]; } while (0)
#define TC_STEP(a_, b_, g_, j, BUF) do { const int ti_ = TC_TILE(j), tr = ti_ / ntc, tc = ti_ % ntc; LAS unsigned char* tl = lds + (BUF) * 9216; \
        asm volatile("" : "+v"(a_), "+v"(b_));     \
        { const float sc_ = RG ? scale * g_ : scale; const f32x4 as = a_ * sc_, bs = b_ * sc_; \
          if constexpr (F8 != 0) { \
              const unsigned w0 = pk4_q<F8>(as[0], as[1], as[2], as[3]), w1 = pk4_q<F8>(bs[0], bs[1], bs[2], bs[3]); \
              _Pragma("unroll") for (int q_ = 0; q_ < 4; ++q_) { tl[(c8 + q_) * 72 + r] = (unsigned char)(w0 >> (8 * q_)); tl[(c8 + 4 + q_) * 72 + r] = (unsigned char)(w1 >> (8 * q_)); } \
          } else { \
              LAS bf16_t* tile = (LAS bf16_t*)tl;                            \
              tile[(c8 + 0) * 72 + r] = f2bf(as[0]); tile[(c8 + 1) * 72 + r] = f2bf(as[1]); tile[(c8 + 2) * 72 + r] = f2bf(as[2]); tile[(c8 + 3) * 72 + r] = f2bf(as[3]); \
              tile[(c8 + 4) * 72 + r] = f2bf(bs[0]); tile[(c8 + 5) * 72 + r] = f2bf(bs[1]); tile[(c8 + 6) * 72 + r] = f2bf(bs[2]); tile[(c8 + 7) * 72 + r] = f2bf(bs[3]); \
          } } \
        TC_LOAD(a_, b_, g_, (j) + 2); \
        asm volatile("s_waitcnt lgkmcnt(0)\n\ts_barrier" ::: "memory"); \
        { const int c = tid >> 3, r8 = (tid & 7) * 8; \
          if constexpr (F8 != 0) { const u32x2 w = *(const LAS u32x2*)(tl + c * 72 + r8); \
              *(u32x2*)((unsigned char*)dstv + (size_t)(row_off + tc * 64 + c) * ldd + tr * 64 + r8) = w; } \
          else { const u32x4 w = *(const LAS u32x4*)((LAS bf16_t*)tl + c * 72 + r8); \
              *(u32x4*)((bf16_t*)dstv + (size_t)(row_off + tc * 64 + c) * ldd + tr * 64 + r8) = w; } } } while (0)
#define TC_PLACEHOLDER(j) do { const int ti_ = TC_TILE(j), tr = ti_ / ntc, tc = ti_ % ntc; const int c = tid >> 3, r8 = (tid & 7) * 8; \
        if constexpr (F8 != 0) *(u32x2*)((unsigned char*)dstv + (size_t)(row_off + tc * 64 + c) * ldd + tr * 64 + r8) = (u32x2){0u, 0u}; \
        else *(u32x4*)((bf16_t*)dstv + (size_t)(row_off + tc * 64 + c) * ldd + tr * 64 + r8) = (u32x4){0u, 0u, 0u, 0u}; } while (0)
    TC_LOAD(aA, bA, gA, 0); __builtin_amdgcn_sched_barrier(0); TC_PLACEHOLDER(0); __builtin_amdgcn_sched_barrier(0);
    TC_LOAD(aB, bB, gB, 1); __builtin_amdgcn_sched_barrier(0); TC_PLACEHOLDER(1); __builtin_amdgcn_sched_barrier(0);
    for (int j = 0; j < nw; j += 2) {
        TC_STEP(aA, bA, gA, j, 0);
        TC_STEP(aB, bB, gB, j + 1, 1);
    }
#undef TC_TILE
#undef TC_LOAD
#undef TC_STEP
#undef TC_PLACEHOLDER
    __syncthreads();
}
__device__ __forceinline__ void rmsnorm_rows_i8(const float* x, const float* gain, unsigned char* out, int nrows, int wave_gid, int nwaves, LAS unsigned char* lds) {
    const int tid = threadIdx.x, lane = tid & 63, wid = tid >> 6;
    for (int i = tid; i < DM / 4; i += 512) *(LAS f32x4*)(lds + i * 16) = *(const f32x4*)(gain + i * 4);
    __syncthreads();
    LAS unsigned char* strip = lds + 16384 + wid * 4096;
    int row = wave_gid;
    if (row < nrows) {
        f32x4 v[16], vn[16];
#pragma unroll
        for (int i = 0; i < 16; ++i) v[i] = *(const f32x4*)(x + (size_t)row * DM + lane * 4 + i * 256);
        for (; row < nrows; row += nwaves) {
            const int nrow = row + nwaves < nrows ? row + nwaves : row;
#pragma unroll
            for (int i = 0; i < 16; ++i) vn[i] = *(const f32x4*)(x + (size_t)nrow * DM + lane * 4 + i * 256);
            float ss = 0.f;
#pragma unroll
            for (int i = 0; i < 16; ++i) ss += (v[i][0] * v[i][0] + v[i][1] * v[i][1]) + (v[i][2] * v[i][2] + v[i][3] * v[i][3]);
            ss = wave_allsum(ss);
            const float rs = __builtin_amdgcn_rsqf(ss * (1.0f / DM) + EPS) * H_I8;
#pragma unroll
            for (int i = 0; i < 16; ++i) { const f32x4 g = *(const LAS f32x4*)(lds + (i * 256 + lane * 4) * 4);
                *(LAS unsigned*)(strip + i * 256 + lane * 4) = pk4_i8(v[i][0] * rs * g[0], v[i][1] * rs * g[1], v[i][2] * rs * g[2], v[i][3] * rs * g[3]); }
#pragma unroll
            for (int j = 0; j < 4; ++j) { const u32x4 w = *(const LAS u32x4*)(strip + j * 1024 + lane * 16);
                *(u32x4*)(out + (size_t)row * DM + j * 1024 + lane * 16) = w; }
#pragma unroll
            for (int i = 0; i < 16; ++i) v[i] = vn[i];
        }
    }
    __syncthreads();
}
template <int MODE>
__device__ __forceinline__ void rmsnorm_rows(const float* x, const float* gain, void* outv, unsigned char* out8, int nrows, int wave_gid, int nwaves) {
    const int lane = threadIdx.x & 63;
    int row = wave_gid; if (row >= nrows) return;
    f32x4 v[16], vn[16];
#pragma unroll
    for (int i = 0; i < 16; ++i) v[i] = *(const f32x4*)(x + (size_t)row * DM + lane * 4 + i * 256);
    for (; row < nrows; row += nwaves) {
        const int nrow = row + nwaves;
        if (nrow < nrows) {
#pragma unroll
            for (int i = 0; i < 16; ++i) vn[i] = *(const f32x4*)(x + (size_t)nrow * DM + lane * 4 + i * 256); }
        float ss = 0.f;
#pragma unroll
        for (int i = 0; i < 16; ++i) ss += (v[i][0] * v[i][0] + v[i][1] * v[i][1]) + (v[i][2] * v[i][2] + v[i][3] * v[i][3]);
        ss = wave_allsum(ss);
        const float rs = __builtin_amdgcn_rsqf(ss * (1.0f / DM) + EPS);
#pragma unroll
        for (int i = 0; i < 16; ++i) { const f32x4 g = *(const f32x4*)(gain + i * 256 + lane * 4);
            const float a = v[i][0] * rs * g[0], b = v[i][1] * rs * g[1], c = v[i][2] * rs * g[2], d = v[i][3] * rs * g[3];
            if constexpr (MODE == 3) *(unsigned*)((unsigned char*)outv + (size_t)row * DM + lane * 4 + i * 256) = pk4_i8(a * H_I8, b * H_I8, c * H_I8, d * H_I8);
            else if constexpr (MODE != 0) *(unsigned*)((MODE == 1 ? (unsigned char*)outv : out8) + (size_t)row * DM + lane * 4 + i * 256) = pk4_fp8(a * H_SCALE, b * H_SCALE, c * H_SCALE, d * H_SCALE);
            if constexpr (MODE != 1 && MODE != 3) { u32x2 w; w.x = cvtpk(a, b); w.y = cvtpk(c, d); *(u32x2*)((bf16_t*)outv + (size_t)row * DM + lane * 4 + i * 256) = w; } }
#pragma unroll
        for (int i = 0; i < 16; ++i) v[i] = vn[i];
    }
}

__device__ __forceinline__ void knorm_rows(bf16_t* base, size_t nrows, const float* gain, int wave_gid, int nwaves) {
    const int lane = threadIdx.x & 63, sub = lane >> 4, l16 = lane & 15;
    const f32x4 g0 = *(const f32x4*)(gain + l16 * 8), g1 = *(const f32x4*)(gain + l16 * 8 + 4);
    for (size_t r16 = (size_t)wave_gid * 16; r16 < nrows; r16 += (size_t)nwaves * 16) {
        bf16x8 raw[4];
#pragma unroll
        for (int u = 0; u < 4; ++u) raw[u] = *(const bf16x8*)(base + (r16 + 4 * u + sub) * 128 + l16 * 8);
#pragma unroll
        for (int u = 0; u < 4; ++u) {
            float v[8]; float ss = 0.f;
#pragma unroll
            for (int j = 0; j < 8; ++j) { v[j] = bf2f((unsigned short)raw[u][j]); ss += v[j] * v[j]; }
            ss = row16_allsum(ss);
            const float rs = __builtin_amdgcn_rsqf(ss * (1.0f / 128.0f) + EPS);
            u32x4 w; w.x = cvtpk(v[0] * rs * g0[0], v[1] * rs * g0[1]); w.y = cvtpk(v[2] * rs * g0[2], v[3] * rs * g0[3]);
            w.z = cvtpk(v[4] * rs * g1[0], v[5] * rs * g1[1]); w.w = cvtpk(v[6] * rs * g1[2], v[7] * rs * g1[3]);
            *(u32x4*)(base + (r16 + 4 * u + sub) * 128 + l16 * 8) = w;
        }
    }
}

constexpr int HR_QT = 0, HR_KET = 17408, HR_PM = 35840, HR_DEC = 45056;
constexpr int RF_QT = 0, RF_PM = 16384, RF_KET = 24576, RF_DEC = 40960, RF_VT = 41472, HR_BYTES = 59904;
constexpr int HP_QH = 46080, HP_KH = 63488, HP_VTF = 80896, HP_TOT = 99328;
constexpr size_t WS_HREC = WS_QMEM;
constexpr size_t WS_V4 = WS_HREC + (size_t)4096 * HR_BYTES + (1u << 20);
constexpr size_t WS_END2 = WS_V4 + (size_t)NEXP * DM / 2;
__device__ __forceinline__ void hgrn_prepass(const Params& p, LAS unsigned char* lds, int wg, int nwg) {
    const int tid = threadIdx.x, wid = __builtin_amdgcn_readfirstlane(tid >> 6), lane = tid & 63, l16 = lane & 15, q4 = lane >> 4;
    const bf16_t* P = (const bf16_t*)(p.ws + WS_P);
    const int k = tid & 127, tq = tid >> 7;
    LAS bf16_t* QT = (LAS bf16_t*)(lds + HR_QT); LAS bf16_t* KET = (LAS bf16_t*)(lds + HR_KET); LAS bf16_t* PM = (LAS bf16_t*)(lds + HR_PM); LAS float* DEC = (LAS float*)(lds + HR_DEC);
    LAS bf16_t* QH = (LAS bf16_t*)(lds + HP_QH); LAS bf16_t* KH = (LAS bf16_t*)(lds + HP_KH); LAS bf16_t* VTF = (LAS bf16_t*)(lds + HP_VTF); LAS float* TOT = (LAS float*)(lds + HP_TOT);
#define HP_BAR() asm volatile("s_waitcnt lgkmcnt(0)\n\ts_barrier" ::: "memory")
    unsigned short rq[16], rf[16]; bf16x8 rv0 = {}, rv1 = {}; float pl0 = 0.f, pl1 = 0.f;
    const int pvs = tid >> 3, pc16 = (tid & 7) * 16;
#define HP_PREFETCH(task_) do { const int t_ = (task_) < 4096 ? (task_) : 4095; const int b_ = t_ >> 10, hh_ = (t_ >> 6) & 15, c_ = t_ & 63; const size_t r0_ = (size_t)b_ * SEQ + (size_t)c_ * 64; \
        const bf16_t* gq_ = P + (size_t)(SL_GQ + hh_) * SLAB + r0_ * 128; const bf16_t* gf_ = P + (size_t)(SL_GF + hh_) * SLAB + r0_ * 128; const bf16_t* gi_ = P + (size_t)(SL_GI + hh_) * SLAB + r0_ * 128; \
        _Pragma("unroll") for (int i = 0; i < 16; ++i) { rq[i] = gq_[(tq * 16 + i) * 128 + k]; rf[i] = gf_[(tq * 16 + i) * 128 + k]; } \
        rv0 = *(const bf16x8*)(gi_ + pvs * 128 + pc16); rv1 = *(const bf16x8*)(gi_ + pvs * 128 + pc16 + 8); \
        pl0 = p.in[I_LB][hh_ * 128 + k]; pl1 = p.in[I_LB][2048 + hh_ * 128 + k]; } while (0)
#define HP_COPYOUT(rec_) do { _Pragma("unroll") for (int i = 0; i < 8; ++i) { int pc = tid + 512 * i; if (i == 7) pc = pc < 3744 ? pc : 3743; \
            const int f_ = (pc >> 6), fl16 = pc & 15, fq4 = (pc >> 4) & 3; int la_; \
            if (i < 2) la_ = HR_QT + ((16 * (f_ >> 2) + fl16) * 136 + 32 * (f_ & 3) + 8 * fq4) * 2; \
            else if (i == 2) la_ = HR_PM + ((16 * ((f_ - 16) >> 1) + fl16) * 72 + 32 * ((f_ - 16) & 1) + 8 * fq4) * 2; \
            else if (i < 5) la_ = HR_KET + ((16 * ((f_ - 24) >> 1) + fl16) * 72 + 32 * ((f_ - 24) & 1) + 8 * fq4) * 2; \
            else la_ = (i == 5 && pc < 2592) ? HR_DEC + (pc - 2560) * 16 : HP_VTF + (pc - 2592) * 16; \
            const u32x4 w = *(const LAS u32x4*)(lds + la_); \
            *(u32x4*)((rec_) + (size_t)pc * 16) = w; } } while (0)
    if (wg >= 4096) return;
    HP_PREFETCH(wg);
    unsigned char* rec_prev = p.ws + WS_HREC + (size_t)wg * HR_BYTES;
    for (int task = wg; task < 4096; task += nwg) {
        HP_COPYOUT(rec_prev);
        HP_BAR();
        rec_prev = p.ws + WS_HREC + (size_t)task * HR_BYTES;
        const float lb = 1.f / (1.f + __expf(pl1 - pl0));
        const float omlb = 1.f - lb;
        float lf[16], kin[16], qv[16];
#pragma unroll
        for (int i = 0; i < 16; ++i) {
            const float g = bf2f(rf[i]), sg = sigmoidf_(g);
            lf[i] = __builtin_amdgcn_logf(lb + omlb * sg);
            kin[i] = omlb * (1.f - sg);
            const float x = bf2f(rq[i]); qv[i] = x * sigmoidf_(x);
        }
        { const bf16x8 v0 = rv0, v1 = rv1;
#pragma unroll
          for (int j = 0; j < 8; ++j) { VTF[(pc16 + j) * 72 + pvs] = (bf16_t)v0[j]; VTF[(pc16 + 8 + j) * 72 + pvs] = (bf16_t)v1[j]; } }
        HP_PREFETCH(task + nwg);
#pragma unroll
        for (int i = 1; i < 16; ++i) lf[i] += lf[i - 1];
        TOT[tq * 128 + k] = lf[15];
        HP_BAR();
        const float t0 = TOT[k], t1 = TOT[128 + k], t2 = TOT[256 + k], t3 = TOT[384 + k];
        const float bmid = t0 + t1, blast = (t0 + t1) + (t2 + t3);
        const float off = tq == 0 ? 0.f : (tq == 1 ? t0 : (tq == 2 ? t0 + t1 : t0 + t1 + t2));
        unsigned ke[8];
#pragma unroll
        for (int i = 0; i < 16; ++i) {
            const float bb = off + lf[i];
            const float e_b = __builtin_amdgcn_exp2f(bb), e_rel = __builtin_amdgcn_exp2f(fminf(bb - bmid, 115.f)), e_inv = __builtin_amdgcn_exp2f(fminf(bmid - bb, 115.f)), e_end = __builtin_amdgcn_exp2f(blast - bb);
            const int t = tq * 16 + i;
            QT[t * 136 + k] = f2bf(qv[i] * e_b);
            QH[t * 136 + k] = f2bf(qv[i] * e_rel);
            KH[t * 136 + k] = f2bf(kin[i] * e_inv);
            const float kev = kin[i] * e_end;
            if (i & 1) ke[i >> 1] = (ke[i >> 1] & 0xffffu) | ((unsigned)f2bf(kev) << 16); else ke[i >> 1] = f2bf(kev);
        }
        *(LAS u32x4*)(KET + k * 72 + tq * 16) = (u32x4){ke[0], ke[1], ke[2], ke[3]};
        *(LAS u32x4*)(KET + k * 72 + tq * 16 + 8) = (u32x4){ke[4], ke[5], ke[6], ke[7]};
        if (tq == 0) DEC[k] = __builtin_amdgcn_exp2f(blast);
        HP_BAR();
        {
            const int tr = wid >> 1;
#pragma unroll
            for (int u = 0; u < 2; ++u) {
                const int tc = (wid & 1) + 2 * u;
                f32x4 a4 = {0.f, 0.f, 0.f, 0.f};
                if (tc <= tr) {
#pragma unroll
                    for (int ks = 0; ks < 4; ++ks) {
                        const bf16x8 A = *(const LAS bf16x8*)(QH + (16 * tr + l16) * 136 + 32 * ks + 8 * q4);
                        const bf16x8 B = *(const LAS bf16x8*)(KH + (16 * tc + l16) * 136 + 32 * ks + 8 * q4);
                        a4 = __builtin_amdgcn_mfma_f32_16x16x32_bf16(A, B, a4, 0, 0, 0);
                    }
                }
#pragma unroll
                for (int j = 0; j < 4; ++j) {
                    const int tl = 4 * q4 + j; float v = a4[j];
                    if (tc > tr || (tc == tr && l16 > tl)) v = 0.f;
                    PM[(16 * tr + tl) * 72 + 16 * tc + l16] = f2bf(v);
                }
            }
        }
        HP_BAR();
    }
    HP_COPYOUT(rec_prev);
    HP_BAR();
#undef HP_COPYOUT
#undef HP_BAR
#undef HP_PREFETCH
}
constexpr int HS_VB = 5120, HS_ST0 = 2 * HS_VB, HS_ST1 = HS_ST0 + 8704, HS_OB = HS_ST1 + 8704, HS_END = HS_OB + 2 * 5120;
struct HsFrag { bf16x8 pm[2], qt[4], ke[2]; };
__device__ __forceinline__ void hgrn_unit(const Params& p, int unit, LAS unsigned char* lds) {
    const int tid = threadIdx.x, wid = __builtin_amdgcn_readfirstlane(tid >> 6), lane = tid & 63, l16 = lane & 15, q4 = lane >> 4;
    const int b = unit >> 6, hh = (unit >> 2) & 15, vq = unit & 3;
    const unsigned char* rec0 = p.ws + WS_HREC + (size_t)((b * 16 + hh) * 64) * HR_BYTES;
    bf16_t* og = (bf16_t*)(p.ws + WS_HGO) + (size_t)b * SEQ * 2048 + hh * 128 + vq * 32;
    const int tr = wid >> 1, tn = wid & 1;
    const int vpc = tid < 320 ? tid : 319;
    const size_t voff = vpc < 288 ? (size_t)RF_VT + vq * 4608 + (size_t)vpc * 16 : (size_t)RF_DEC + (size_t)(vpc - 288) * 16;
    const size_t foff_pm = (size_t)RF_PM + (size_t)((tr * 2) * 64 + lane) * 16, foff_qt = (size_t)RF_QT + (size_t)((tr * 4) * 64 + lane) * 16, foff_ke = (size_t)RF_KET + (size_t)((wid * 2) * 64 + lane) * 16;
#define HS_REC(c) (rec0 + (size_t)((c) < 64 ? (c) : 63) * HR_BYTES)
#define HS_LOADF(F, c) do { const unsigned char* r_ = HS_REC(c); \
        _Pragma("unroll") for (int ks = 0; ks < 2; ++ks) F.pm[ks] = *(const bf16x8*)(r_ + foff_pm + ks * 1024); \
        _Pragma("unroll") for (int ks = 0; ks < 4; ++ks) F.qt[ks] = *(const bf16x8*)(r_ + foff_qt + ks * 1024); \
        _Pragma("unroll") for (int ks = 0; ks < 2; ++ks) F.ke[ks] = *(const bf16x8*)(r_ + foff_ke + ks * 1024); } while (0)
#define HS_LOADV(v, c) do { v = *(const u32x4*)(HS_REC(c) + voff); } while (0)
#define HS_WRITEV(v, VB) do { if (tid < 320) *(LAS u32x4*)(lds + (VB) * HS_VB + tid * 16) = v; } while (0)
#define HS_BAR() asm volatile("s_waitcnt lgkmcnt(0)\n\ts_barrier" ::: "memory")
    for (int i = tid; i < 8704 / 4; i += 512) ((LAS unsigned*)(lds + HS_ST0))[i] = 0u;
    f32x4 Sacc[2] = {(f32x4){0.f, 0.f, 0.f, 0.f}, (f32x4){0.f, 0.f, 0.f, 0.f}};
#define HS_STEP(F, c, VB) do { \
        const LAS bf16_t* VT = (const LAS bf16_t*)(lds + (VB) * HS_VB); const LAS float* DEC = (const LAS float*)(lds + (VB) * HS_VB + 4608); \
        const LAS bf16_t* STc = (const LAS bf16_t*)(lds + ((VB) ? HS_ST1 : HS_ST0)); \
        LAS bf16_t* STn = (LAS bf16_t*)(lds + ((VB) ? HS_ST0 : HS_ST1)); \
        f32x4 oa = {0.f, 0.f, 0.f, 0.f}; \
        _Pragma("unroll") for (int ks = 0; ks < 2; ++ks) { \
            const bf16x8 B = *(const LAS bf16x8*)(VT + (16 * tn + l16) * 72 + 32 * ks + 8 * q4); \
            oa = __builtin_amdgcn_mfma_f32_16x16x32_bf16(F.pm[ks], B, oa, 0, 0, 0); } \
        _Pragma("unroll") for (int ks = 0; ks < 4; ++ks) { \
            const bf16x8 B = *(const LAS bf16x8*)(STc + (16 * tn + l16) * 136 + 32 * ks + 8 * q4); \
            oa = __builtin_amdgcn_mfma_f32_16x16x32_bf16(F.qt[ks], B, oa, 0, 0, 0); } \
        { LAS bf16_t* ob_ = (LAS bf16_t*)(lds + HS_OB + (VB) * 5120); \
          _Pragma("unroll") for (int j = 0; j < 4; ++j) ob_[(16 * tr + 4 * q4 + j) * 40 + 16 * tn + l16] = f2bf(oa[j]); } \
        const f32x4 dc = *(const LAS f32x4*)(DEC + 16 * wid + 4 * q4); \
        _Pragma("unroll") for (int t2 = 0; t2 < 2; ++t2) { \
            f32x4 sv = Sacc[t2] * dc; \
            _Pragma("unroll") for (int ks = 0; ks < 2; ++ks) { \
                const bf16x8 B = *(const LAS bf16x8*)(VT + (16 * t2 + l16) * 72 + 32 * ks + 8 * q4); \
                sv = __builtin_amdgcn_mfma_f32_16x16x32_bf16(F.ke[ks], B, sv, 0, 0, 0); } \
            Sacc[t2] = sv; \
            u32x2 w; w.x = cvtpk(sv[0], sv[1]); w.y = cvtpk(sv[2], sv[3]); \
            *(LAS u32x2*)(STn + (16 * t2 + l16) * 136 + 16 * wid + 4 * q4) = w; } } while (0)
#define HS_OUT(cc, VB) do { const u32x2 w_ = *(const LAS u32x2*)(lds + HS_OB + (VB) * 5120 + (tid >> 3) * 80 + (tid & 7) * 8); \
        *(u32x2*)(og + ((size_t)(cc) * 64 + (tid >> 3)) * 2048 + (tid & 7) * 4) = w_; } while (0)
    HsFrag FA, FB; u32x4 vA, vB;
    HS_LOADF(FA, 0); HS_LOADV(vA, 0); HS_LOADV(vB, 1); HS_LOADF(FB, 1);
    HS_WRITEV(vA, 0);
    HS_BAR();
    for (int c = 0; c < 64; c += 2) {
        HS_LOADV(vA, c + 2);
        HS_OUT(c == 0 ? 0 : c - 1, 1);
        HS_STEP(FA, c, 0);
        HS_WRITEV(vB, 1);
        HS_LOADF(FA, c + 2);
        HS_BAR();
        HS_LOADV(vB, c + 3);
        HS_OUT(c, 0);
        HS_STEP(FB, c + 1, 1);
        HS_WRITEV(vA, 0);
        HS_LOADF(FB, c + 3);
        HS_BAR();
    }
    HS_OUT(63, 1);
#undef HS_OUT
#undef HS_REC
#undef HS_LOADF
#undef HS_LOADV
#undef HS_WRITEV
#undef HS_STEP
#undef HS_BAR
}

__device__ __forceinline__ att::BlockRef diff_ref(const Params& p, int L, int pass) {
    const int ph = L >> 3, x = L & 7, qb = pass ? 15 - x : x;
    const int b = ph >> 5, h = (ph >> 2) & 7, m = (ph >> 1) & 1, e = ph & 1;
    bf16_t* P = (bf16_t*)(p.ws + WS_P);
    att::BlockRef r;
    r.Q = P + (size_t)(SL_DQ + h * 2 + m) * SLAB + ((size_t)b * SEQ + qb * 256) * 128;
    r.K = P + (size_t)(SL_DK + h * 2 + m) * SLAB + (size_t)b * SEQ * 128;
    r.V = P + (size_t)(SL_DV + h * 2 + e) * SLAB + (size_t)b * SEQ * 128;
    r.O = (bf16_t*)(p.ws + WS_A) + (size_t)((h * 2 + m) * 2 + e) * SLAB + ((size_t)b * SEQ + qb * 256) * 128;
    r.P0 = qb * 256;
    return r;
}
__device__ __forceinline__ int diff_item(int wg, int G, int r) {
    if (G != 256) return wg + r * G;
    const int j = wg >> 3, bh = r * 8 + (wg & 7);
    return (bh * 4 + (j >> 3)) * 8 + (j & 7);
}
__device__ __forceinline__ att::BlockRef diff_ref2(const Params& p, int ph, int qb) {
    return diff_ref(p, ph * 8 + (qb < 8 ? qb : 15 - qb), qb < 8 ? 0 : 1);
}
constexpr int AQ_WORD = 3600, AQ_SLOT = 69632;
__device__ __forceinline__ int diff_claim(const Params& p, LAS unsigned char* ldsl) {
    if (threadIdx.x == 0) {
        const unsigned i = __hip_atomic_fetch_add((unsigned*)(p.ws + WS_CTL) + AQ_WORD + 16 * (blockIdx.x & 7), 1u, __ATOMIC_RELAXED, __HIP_MEMORY_SCOPE_AGENT);
        *(LAS int*)(ldsl + AQ_SLOT) = i < 128u ? (int)i : -1;
    }
    asm volatile("s_waitcnt lgkmcnt(0)\n\ts_barrier" ::: "memory");
    const int r = *(const LAS int*)(ldsl + AQ_SLOT);
    return __builtin_amdgcn_readfirstlane(r);
}
__device__ __forceinline__ void diff_attn_phase(const Params& p, char* lds, LAS unsigned char* ldsl) {
    const int total = 1024, G = gridDim.x, wg = blockIdx.x;
    const int nr = (total - wg + G - 1) / G;
    if (nr <= 0) return;
    const bool dyn = (G == 256);
    const int nrs = dyn ? 2 : nr;
    int r = 0, pass = 0;
    int L = diff_item(wg, G, 0);
    att::BlockRef cur = diff_ref(p, L, 0);
    att::Seam S;
    att::attn_prime(cur, lds, S);
    int dk = -2;
    for (;;) {
        att::BlockRef nxt = cur; bool last;
        if (dk == -2) {
            const bool more_pass = pass == 0, more_item = r + 1 < nrs;
            if (more_pass || more_item) {
                int passn = pass + 1, rn = r, Ln = L;
                if (!more_pass) { passn = 0; rn = r + 1; Ln = diff_item(wg, G, rn); }
                nxt = diff_ref(p, Ln, passn); pass = passn; L = Ln; r = rn; last = false;
            } else if (dyn) {
                dk = diff_claim(p, ldsl);
                if (dk >= 0) { nxt = diff_ref2(p, (16 + 8 * (dk >> 6) + (wg & 7)) * 4 + (dk & 3), 15 - ((dk & 63) >> 2)); last = false; } else last = true;
            } else last = true;
        } else {
            dk = diff_claim(p, ldsl);
            if (dk >= 0) { nxt = diff_ref2(p, (16 + 8 * (dk >> 6) + (wg & 7)) * 4 + (dk & 3), 15 - ((dk & 63) >> 2)); last = false; } else last = true;
        }
        att::attn_block<true>(cur, nxt, SEQ, 128, p.in[I_DQN], lds, S);
        if (last) break;
        cur = nxt;
    }
}

__device__ __forceinline__ void mixfinal_phase(const Params& p, int wave_gid, int nwaves) {
    const int lane = threadIdx.x & 63, half = lane >> 5, d4 = (lane & 31) * 4;
    float lam;
    { const float a = p.in[I_LQ1][lane] * p.in[I_LK1][lane] + p.in[I_LQ1][lane + 64] * p.in[I_LK1][lane + 64];
      const float c = p.in[I_LQ2][lane] * p.in[I_LK2][lane] + p.in[I_LQ2][lane + 64] * p.in[I_LK2][lane + 64];
      lam = __expf(wave_allsum(a)) - __expf(wave_allsum(c)) + 0.2f; }
    const bf16_t* AO = (const bf16_t*)(p.ws + WS_A);
    const bf16_t* HGO = (const bf16_t*)(p.ws + WS_HGO);
    const bf16_t* P = (const bf16_t*)(p.ws + WS_P);
    bf16_t* mixed = (bf16_t*)(p.ws + WS_P);
    const f32x4 gsub = *(const f32x4*)(p.in[I_SUBLN] + half * 128 + d4), ghg = *(const f32x4*)(p.in[I_HGN] + d4);
    for (int tok = wave_gid; tok < NTOK; tok += nwaves) {
        u32x2 a0[8], a1[8], ho[8], hg[8];
#pragma unroll
        for (int h = 0; h < 8; ++h) {
            a0[h] = *(const u32x2*)(AO + (size_t)((h * 2 + 0) * 2 + half) * SLAB + (size_t)tok * 128 + d4);
            a1[h] = *(const u32x2*)(AO + (size_t)((h * 2 + 1) * 2 + half) * SLAB + (size_t)tok * 128 + d4);
            const int hh = 2 * h + half;
            ho[h] = *(const u32x2*)(HGO + (size_t)tok * 2048 + hh * 128 + d4);
            hg[h] = *(const u32x2*)(P + (size_t)(SL_GG + hh) * SLAB + (size_t)tok * 128 + d4);
        }
#pragma unroll
        for (int h = 0; h < 8; ++h) {
            const int e = half;
            const u32x2 r0 = a0[h], r1 = a1[h];
            float d[4];
            d[0] = __uint_as_float(r0.x << 16) - lam * __uint_as_float(r1.x << 16); d[1] = __uint_as_float(r0.x & 0xffff0000u) - lam * __uint_as_float(r1.x & 0xffff0000u);
            d[2] = __uint_as_float(r0.y << 16) - lam * __uint_as_float(r1.y << 16); d[3] = __uint_as_float(r0.y & 0xffff0000u) - lam * __uint_as_float(r1.y & 0xffff0000u);
            float ss = (d[0] * d[0] + d[1] * d[1]) + (d[2] * d[2] + d[3] * d[3]);
            ss = wave_allsum(ss);
            const float rs = __builtin_amdgcn_rsqf(ss * (1.0f / 256.0f) + EPS) * 0.8f;
            const f32x4 g = gsub;
            if (WO_MODE == 2) *(unsigned*)((unsigned char*)mixed + (size_t)tok * DM + h * 256 + e * 128 + d4) = pk4_i8(d[0] * rs * g[0] * MIX_I8, d[1] * rs * g[1] * MIX_I8, d[2] * rs * g[2] * MIX_I8, d[3] * rs * g[3] * MIX_I8);
            else { u32x2 w; w.x = cvtpk(d[0] * rs * g[0], d[1] * rs * g[1]); w.y = cvtpk(d[2] * rs * g[2], d[3] * rs * g[3]);
            *(u32x2*)(mixed + (size_t)tok * DM + h * 256 + e * 128 + d4) = w; }
        }
#pragma unroll
        for (int h = 0; h < 8; ++h) {
            const int hh = 2 * h + half;
            const u32x2 r0 = ho[h], rg = hg[h];
            float o[4], gg[4];
            o[0] = __uint_as_float(r0.x << 16); o[1] = __uint_as_float(r0.x & 0xffff0000u); o[2] = __uint_as_float(r0.y << 16); o[3] = __uint_as_float(r0.y & 0xffff0000u);
            gg[0] = __uint_as_float(rg.x << 16); gg[1] = __uint_as_float(rg.x & 0xffff0000u); gg[2] = __uint_as_float(rg.y << 16); gg[3] = __uint_as_float(rg.y & 0xffff0000u);
            float ss = (o[0] * o[0] + o[1] * o[1]) + (o[2] * o[2] + o[3] * o[3]);
            ss = half_allsum(ss);
            const float rs = __builtin_amdgcn_rsqf(ss * (1.0f / 128.0f) + EPS);
            const f32x4 g = ghg;
            float r[4];
#pragma unroll
            for (int i = 0; i < 4; ++i) r[i] = o[i] * rs * g[i] * (gg[i] * sigmoidf_(gg[i]));
            if (WO_MODE == 2) *(unsigned*)((unsigned char*)mixed + (size_t)tok * DM + 2048 + hh * 128 + d4) = pk4_i8(r[0] * MIX_I8, r[1] * MIX_I8, r[2] * MIX_I8, r[3] * MIX_I8);
            else { u32x2 w; w.x = cvtpk(r[0], r[1]); w.y = cvtpk(r[2], r[3]);
            *(u32x2*)(mixed + (size_t)tok * DM + 2048 + hh * 128 + d4) = w; }
        }
    }
}

__device__ __forceinline__ unsigned pk8_fp4(const f32x4 a, const f32x4 b) {
    unsigned w = 0u;
    w = __builtin_amdgcn_cvt_scalef32_pk_fp4_f32(w, a[0], a[1], 1.0f, 0); w = __builtin_amdgcn_cvt_scalef32_pk_fp4_f32(w, a[2], a[3], 1.0f, 1);
    w = __builtin_amdgcn_cvt_scalef32_pk_fp4_f32(w, b[0], b[1], 1.0f, 2); w = __builtin_amdgcn_cvt_scalef32_pk_fp4_f32(w, b[2], b[3], 1.0f, 3);
    return w;
}
__device__ __forceinline__ void cvt_fp8_table(const float* src, unsigned char* dst, float scale, int gtid, int nthreads) {
    const size_t n16 = (size_t)NEXP * DM / 16;
#if TAB_BITS == 8
    for (size_t i = gtid; i < n16; i += nthreads) {
        const float* s = src + i * 16;
        const f32x4 a = *(const f32x4*)s * scale, b = *(const f32x4*)(s + 4) * scale, c = *(const f32x4*)(s + 8) * scale, d = *(const f32x4*)(s + 12) * scale;
        u32x4 w; w.x = pk4_fp8(a[0], a[1], a[2], a[3]); w.y = pk4_fp8(b[0], b[1], b[2], b[3]); w.z = pk4_fp8(c[0], c[1], c[2], c[3]); w.w = pk4_fp8(d[0], d[1], d[2], d[3]);
        *(u32x4*)(dst + i * 16) = w;
    }
#else
    for (size_t i = gtid; i < n16; i += (size_t)nthreads * 4) {
        f32x4 v[4][4];
#pragma unroll
        for (int u = 0; u < 4; ++u) { const size_t iu = i + (size_t)u * nthreads; if (iu < n16) { const float* s = src + iu * 16;
#pragma unroll
            for (int q = 0; q < 4; ++q) v[u][q] = *(const f32x4*)(s + 4 * q); } }
#pragma unroll
        for (int u = 0; u < 4; ++u) { const size_t iu = i + (size_t)u * nthreads; if (iu < n16)
            *(u32x2*)(dst + iu * 8) = (u32x2){pk8_fp4(v[u][0] * scale, v[u][1] * scale), pk8_fp4(v[u][2] * scale, v[u][3] * scale)}; }
    }
#endif
}
__device__ __forceinline__ att::BlockRef mem_ref(const Params& p, int L) {
    const int b = L >> 6, h = (L >> 4) & 3, qb = L & 15;
    att::BlockRef r;
    r.Q = (const bf16_t*)(p.ws + WS_QMEM) + (size_t)h * SLAB + ((size_t)b * SEQ + qb * 256) * 128;
    r.K = (const bf16_t*)(p.ws + WS_MEMKV) + (size_t)h * (NMEM * 128) + (size_t)b * MEM_LEN * 128;
    r.V = (const bf16_t*)(p.ws + WS_MEMKV) + (size_t)(4 + h) * (NMEM * 128) + (size_t)b * MEM_LEN * 128;
    r.O = (bf16_t*)(p.ws + WS_OMEM) + ((size_t)b * SEQ + qb * 256) * 512 + h * 128;
    r.P0 = 0;
    return r;
}
__device__ __forceinline__ void mem_attn_phase(const Params& p, char* lds) {
    const int total = 256, stride = gridDim.x;
    int L = blockIdx.x; if (L >= total) return;
    att::BlockRef cur = mem_ref(p, L);
    att::Seam S;
    att::attn_prime(cur, lds, S);
    for (;;) {
        const bool last = L + stride >= total;
        const att::BlockRef nxt = last ? cur : mem_ref(p, L + stride);
        att::attn_block<false>(cur, nxt, MEM_LEN, 512, p.in[I_MQN], lds, S);
        if (last) break;
        cur = nxt; L += stride;
    }
}

__device__ __forceinline__ unsigned f2key(float v) { const unsigned u = __float_as_uint(v); return (u & 0x80000000u) ? ~u : (u | 0x80000000u); }
__device__ __forceinline__ float key2f(unsigned k) { return __uint_as_float((k & 0x80000000u) ? (k & 0x7fffffffu) : ~k); }
#define KEY_INSERT(K, k_) do { unsigned nk_ = (k_); _Pragma("unroll") for (int s_ = 0; s_ < 16; ++s_) { const unsigned hi_ = K[s_] > nk_ ? K[s_] : nk_; nk_ = K[s_] > nk_ ? nk_ : K[s_]; K[s_] = hi_; } } while (0)
#define KEY_CE(a_, b_) do { const unsigned hi_ = (a_) > (b_) ? (a_) : (b_), lo_ = (a_) > (b_) ? (b_) : (a_); (a_) = hi_; (b_) = lo_; } while (0)
__device__ __forceinline__ void key_bitonic_merge16(unsigned (&a)[16]) {
#pragma unroll
    for (int j = 8; j > 0; j >>= 1)
#pragma unroll
        for (int i = 0; i < 16; ++i) { const int l = i ^ j; if (l > i) KEY_CE(a[i], a[l]); }
}
__device__ __forceinline__ void key_sort16(unsigned (&a)[16]) {
#pragma unroll
    for (int k = 2; k <= 16; k <<= 1)
#pragma unroll
        for (int j = k >> 1; j > 0; j >>= 1)
#pragma unroll
            for (int i = 0; i < 16; ++i) { const int l = i ^ j; if (l > i) { if ((i & k) == 0) KEY_CE(a[i], a[l]); else KEY_CE(a[l], a[i]); } }
}
__device__ __forceinline__ void key_top16_merge(unsigned (&K)[16], const unsigned (&T)[16]) {
#pragma unroll
    for (int s = 0; s < 16; ++s) K[s] = K[s] > T[15 - s] ? K[s] : T[15 - s];
    key_bitonic_merge16(K);
}
__device__ __forceinline__ void peer_topk_phase(const Params& p, LAS unsigned char* lds, int wid, int wave_gid, int nwaves) {
    const int lane = threadIdx.x & 63, r32 = lane & 31, hi = lane >> 5;
    const bf16_t* qp = (const bf16_t*)(p.ws + WS_P) + (size_t)64 * SLAB;
    const bf16_t* keys = (const bf16_t*)(p.ws + WS_KEYS);
    int* exps = (int*)(p.ws + WS_EXP); float* gates = (float*)(p.ws + WS_GATE);
    LAS unsigned* lk = (LAS unsigned*)(lds + wid * 8192);
    for (int task = wave_gid; task < (NTOK / 32) * 8; task += nwaves) {
        const int tile = task >> 3, h = task & 7, tok = tile * 32 + r32;
        unsigned K0[16], K1[16];
#pragma unroll 1
        for (int pp = 0; pp < 2; ++pp) {
            bf16x8 bq[8];
#pragma unroll
            for (int j = 0; j < 8; ++j) bq[j] = *(const bf16x8*)(qp + (size_t)tok * 2048 + h * 256 + pp * 128 + 16 * j + 8 * hi);
            unsigned K[16];
#pragma unroll
            for (int s = 0; s < 16; ++s) K[s] = 0u;
            const bf16_t* kb0 = keys + ((size_t)(h * 2 + pp) * 128 + r32) * 128 + 8 * hi;
            bf16x8 ka[8];
#pragma unroll
            for (int j = 0; j < 8; ++j) ka[j] = *(const bf16x8*)(kb0 + 16 * j);
#pragma unroll 1
            for (int i = 0; i < 4; ++i) {
                f32x16 acc = {};
#pragma unroll
                for (int j = 0; j < 8; ++j) acc = __builtin_amdgcn_mfma_f32_32x32x16_bf16(ka[j], bq[j], acc, 0, 0, 0);
                if (i < 3) {
#pragma unroll
                    for (int j = 0; j < 8; ++j) ka[j] = *(const bf16x8*)(kb0 + (size_t)(32 * (i + 1)) * 128 + 16 * j); }
                const unsigned pay0 = 127u - (unsigned)(32 * i + 4 * hi);
                unsigned T[16];
#pragma unroll
                for (int r = 0; r < 16; ++r) T[r] = (f2key(acc[r]) & ~127u) | (pay0 - (unsigned)((r & 3) + 8 * (r >> 2)));
                key_sort16(T); key_top16_merge(K, T);
            }
            unsigned O[16];
#pragma unroll
            for (int s = 0; s < 16; ++s) O[s] = (unsigned)__shfl_xor((int)K[s], 32);
            key_top16_merge(K, O);
#pragma unroll
            for (int s = 0; s < 16; ++s) { if (pp == 0) K0[s] = K[s]; else K1[s] = K[s]; }
        }
        float v0[16], v1[16];
#pragma unroll
        for (int s = 0; s < 16; ++s) { v0[s] = key2f(K0[s] & ~127u); v1[s] = key2f(K1[s] & ~127u); lk[s * 64 + lane] = K0[s]; lk[(16 + s) * 64 + lane] = K1[s]; }
#define CK(a_, b_) ((f2key(v0[a_] + v1[b_]) & ~255u) | (unsigned)(255 - (16 * (a_) + (b_))))
        unsigned B[16], T1[16], T2[16];
#pragma unroll
        for (int b2 = 0; b2 < 16; ++b2) B[b2] = CK(0, b2);
#pragma unroll
        for (int b2 = 0; b2 < 8; ++b2) T1[b2] = CK(1, b2);
#pragma unroll
        for (int b2 = 0; b2 < 5; ++b2) T1[8 + b2] = CK(2, b2);
#pragma unroll
        for (int b2 = 0; b2 < 3; ++b2) T1[13 + b2] = CK(3, b2);
        T2[0] = CK(3, 3);
#pragma unroll
        for (int b2 = 0; b2 < 3; ++b2) T2[1 + b2] = CK(4, b2);
#pragma unroll
        for (int a = 5; a < 8; ++a) { T2[4 + 2 * (a - 5)] = CK(a, 0); T2[5 + 2 * (a - 5)] = CK(a, 1); }
#pragma unroll
        for (int a = 8; a < 14; ++a) T2[10 + (a - 8)] = CK(a, 0);
        key_sort16(T1); key_top16_merge(B, T1);
        key_sort16(T2); key_top16_merge(B, T2);
        KEY_INSERT(B, CK(14, 0)); KEY_INSERT(B, CK(15, 0));
#undef CK
        float ev[16], den = 0.f; int ex[16];
        const float best = key2f(B[0] & ~255u);
#pragma unroll
        for (int s = 0; s < 16; ++s) {
            const unsigned pos = 255u - (B[s] & 255u);
            const unsigned ka = lk[(pos >> 4) * 64 + lane], kb2 = lk[(16 + (pos & 15)) * 64 + lane];
            ex[s] = (int)(((127u - (ka & 127u)) << 7) | (127u - (kb2 & 127u)));
            ev[s] = __expf(key2f(B[s] & ~255u) - best); den += ev[s];
        }
        const float inv = 1.0f / den;
        if (hi == 0) {
            int* ep = exps + (size_t)tok * 128 + h * 16; float* gp = gates + (size_t)tok * 128 + h * 16;
#pragma unroll
            for (int s4 = 0; s4 < 4; ++s4) {
                *(int4*)(ep + 4 * s4) = make_int4(ex[4 * s4], ex[4 * s4 + 1], ex[4 * s4 + 2], ex[4 * s4 + 3]);
                *(f32x4*)(gp + 4 * s4) = (f32x4){ev[4 * s4] * inv, ev[4 * s4 + 1] * inv, ev[4 * s4 + 2] * inv, ev[4 * s4 + 3] * inv};
            }
        }
    }
}

#if TAB_BITS == 8
constexpr int G_NJ = 4, G_EPJ = 16, G_R = 4;
#else
constexpr int G_NJ = 2, G_EPJ = 32, G_R = 4;
#endif
constexpr int G_JSTR = 64 * G_EPJ;
__device__ __forceinline__ void tab_dec(unsigned w, float (&o)[32 / TAB_BITS]) {
#if TAB_BITS == 8
    const f32x2 lo = __builtin_amdgcn_cvt_pk_f32_fp8((int)w, false), hi = __builtin_amdgcn_cvt_pk_f32_fp8((int)w, true);
    o[0] = lo.x; o[1] = lo.y; o[2] = hi.x; o[3] = hi.y;
#else
    const f32x2 a = __builtin_amdgcn_cvt_scalef32_pk_f32_fp4(w, 1.0f, 0), b = __builtin_amdgcn_cvt_scalef32_pk_f32_fp4(w, 1.0f, 1);
    const f32x2 c = __builtin_amdgcn_cvt_scalef32_pk_f32_fp4(w, 1.0f, 2), d = __builtin_amdgcn_cvt_scalef32_pk_f32_fp4(w, 1.0f, 3);
    o[0] = a.x; o[1] = a.y; o[2] = b.x; o[3] = b.y; o[4] = c.x; o[5] = c.y; o[6] = d.x; o[7] = d.y;
#endif
}
__device__ __forceinline__ float gelu_erf(float v) {
    const float av = fabsf(v), t = __builtin_amdgcn_rcpf(av * 0.2316418882f + 1.0f);
    float q = t * 0.5307027145f + (-0.7265760135f); q = q * t + 0.7107068705f; q = q * t + (-0.142248368f); q = q * t + 0.127414796f; q = q * t;
    const float e = __builtin_amdgcn_exp2f((v * v) * (-0.72134752044f));
    const float m = v * (q * e);
    return v < 0.f ? m : v - m;
}
#if TAB_BITS == 4
constexpr int GR_NS = 6, GR_RING = GR_NS * 2048, GR_H8 = 8 * GR_RING, GR_W = 131072 + 1024;
constexpr float H4_SCALE = 2.f;
__device__ __forceinline__ void peer_gather_phase(const Params& p, float* dst, LAS unsigned char* lds, int wid, int wave_gid, int nwaves) {
    const int lane = threadIdx.x & 63, l16 = lane & 15, g4 = lane >> 4;
    const unsigned char* u8 = p.ws + WS_P + (size_t)80 * SLAB * 2;
    const unsigned char* v8 = p.ws + (TAB_BITS == 4 ? WS_V4 : WS_HGO);
    const bf16_t* x2b = (const bf16_t*)(p.ws + WS_P);
    const int* exps = (const int*)(p.ws + WS_EXP); const float* gates = (const float*)(p.ws + WS_GATE);
    const unsigned long long* rowss2 = (const unsigned long long*)(p.ws + WS_ROWSS2);
    LAS unsigned char* ring = lds + wid * GR_RING;
    LAS unsigned char* h8 = lds + GR_H8 + wid * 4096;
    LAS float* wl = (LAS float*)(lds + GR_W + wid * 512);
    const unsigned rd0 = (unsigned)(uintptr_t)ring + (unsigned)lane * 16u;
    int tok = wave_gid; if (tok >= NTOK) return;
    int e0 = exps[(size_t)tok * 128 + lane], e1 = exps[(size_t)tok * 128 + 64 + lane];
#define G_ISSUE(ea, eb, slot, rs) do { const int e_ = __builtin_amdgcn_readlane((slot) < 64 ? (ea) : (eb), (slot) & 63); \
        const unsigned char* row_ = v8 + (size_t)e_ * TAB_ROW + lane * 16; \
        __builtin_amdgcn_global_load_lds((const unsigned*)row_, (LAS unsigned*)(ring + (rs) * 2048), 16, 0, 0); \
        __builtin_amdgcn_global_load_lds((const unsigned*)(row_ + 1024), (LAS unsigned*)(ring + (rs) * 2048 + 1024), 16, 0, 0); } while (0)
#define G_READ(ra, rb, addr) asm volatile("s_waitcnt vmcnt(10)\n\tds_read_b128 %0, %2\n\tds_read_b128 %1, %2 offset:1024\n\ts_waitcnt lgkmcnt(0)" : "=&v"(ra), "=&v"(rb) : "v"(addr) : "memory")
#pragma unroll
    for (int k = 0; k < GR_NS; ++k) G_ISSUE(e0, e1, k, k);
    int rs = 0;
    unsigned* tokq = (unsigned*)(p.ws + WS_CTL) + 3584;
    while (tok < NTOK) {
        unsigned nt_ = 0u; if (lane == 0) nt_ = (unsigned)nwaves + __hip_atomic_fetch_add(tokq, 1u, __ATOMIC_RELAXED, __HIP_MEMORY_SCOPE_AGENT);
        { const float r2 = rowscale(rowss2, tok) * H4_SCALE;
#pragma unroll
          for (int j = 0; j < 2; ++j) {
              u32x4 whi, wlo;
              f32x4 xq[8];
#pragma unroll
              for (int qq = 0; qq < 4; ++qq) bf8_f32(*(const u32x4*)(x2b + (size_t)tok * DM + j * 2048 + lane * 32 + 8 * qq), xq[2 * qq], xq[2 * qq + 1]);
#pragma unroll
              for (int q = 0; q < 8; ++q) {
                  const f32x4 xv = xq[q], gv = *(const f32x4*)(p.in[I_FFNN] + j * 2048 + lane * 32 + 4 * q);
                  const float h0 = xv[0] * gv[0] * r2, h1 = xv[1] * gv[1] * r2, h2 = xv[2] * gv[2] * r2, h3 = xv[3] * gv[3] * r2;
                  unsigned hb = 0u; hb = __builtin_amdgcn_cvt_scalef32_pk_fp4_f32(hb, h0, h1, 1.0f, 0); hb = __builtin_amdgcn_cvt_scalef32_pk_fp4_f32(hb, h2, h3, 1.0f, 1);
                  const f32x2 d01 = __builtin_amdgcn_cvt_scalef32_pk_f32_fp4(hb, 1.0f, 0), d23 = __builtin_amdgcn_cvt_scalef32_pk_f32_fp4(hb, 1.0f, 1);
                  unsigned lb = 0u; lb = __builtin_amdgcn_cvt_scalef32_pk_fp4_f32(lb, (h0 - d01.x) * 4.f, (h1 - d01.y) * 4.f, 1.0f, 0); lb = __builtin_amdgcn_cvt_scalef32_pk_fp4_f32(lb, (h2 - d23.x) * 4.f, (h3 - d23.y) * 4.f, 1.0f, 1);
                  if (q & 1) { whi[q >> 1] |= (hb & 0xffffu) << 16; wlo[q >> 1] |= (lb & 0xffffu) << 16; } else { whi[q >> 1] = hb & 0xffffu; wlo[q >> 1] = lb & 0xffffu; }
              }
              *(LAS u32x4*)(h8 + j * 1024 + lane * 16) = whi; *(LAS u32x4*)(h8 + 2048 + j * 1024 + lane * 16) = wlo;
          } }
        asm volatile("s_waitcnt lgkmcnt(0)" ::: "memory");
        {
            i32x4_t aL[16], aH[16];
            int elT[8], gtmp = 0;
#pragma unroll
            for (int T = 0; T < 8; ++T) elT[T] = exps[(size_t)tok * 128 + 16 * T + l16];
            (void)gtmp;
            const unsigned h8t0 = (unsigned)(uintptr_t)h8 + 16u * g4;
#define U_LOAD(buf, T_, half) do { const unsigned char* rp_ = u8 + (size_t)elT[T_] * TAB_ROW + g4 * 16 + (half) * 1024; \
            _Pragma("unroll") for (int t = 0; t < 16; ++t) buf[t] = *(const i32x4_t*)(rp_ + t * 64); } while (0)
#define U_MMA(buf, half) do { unsigned h8t = h8t0 + (half) * 1024u; asm volatile("" : "+v"(h8t)); \
            _Pragma("unroll") for (int t = 0; t < 16; ++t) { \
                const i32x4_t bh = *(const LAS i32x4_t*)(uintptr_t)(h8t + 64 * t), bl = *(const LAS i32x4_t*)(uintptr_t)(h8t + 2048 + 64 * t); \
                const pg8::i32x8 a8 = __builtin_shufflevector(buf[t], buf[t], 0, 1, 2, 3, -1, -1, -1, -1); \
                const pg8::i32x8 bh8 = __builtin_shufflevector(bh, bh, 0, 1, 2, 3, -1, -1, -1, -1), bl8 = __builtin_shufflevector(bl, bl, 0, 1, 2, 3, -1, -1, -1, -1); \
                acc = __builtin_amdgcn_mfma_scale_f32_16x16x128_f8f6f4(a8, bh8, acc, 4, 4, 0, 127, 0, 127); \
                acc = __builtin_amdgcn_mfma_scale_f32_16x16x128_f8f6f4(a8, bl8, acc, 4, 4, 0, 127, 0, 125); \
                if ((t & 3) == 3) __builtin_amdgcn_sched_barrier(0); } } while (0)
            U_LOAD(aL, 0, 0); U_LOAD(aH, 0, 1);
#pragma unroll
            for (int T = 0; T < 8; ++T) {
                f32x4 acc = {0.f, 0.f, 0.f, 0.f};
                __builtin_amdgcn_sched_barrier(0);
                U_MMA(aL, 0);
                if (T < 7) U_LOAD(aL, T + 1, 0);
                __builtin_amdgcn_sched_barrier(0);
                U_MMA(aH, 1);
                if (T < 7) U_LOAD(aH, T + 1, 1);
                __builtin_amdgcn_sched_barrier(0);
                f32x4 w4;
#pragma unroll
                for (int j = 0; j < 4; ++j) w4[j] = acc[j];
                *(LAS f32x4*)(wl + 16 * T + 4 * g4) = w4;
            }
#undef U_LOAD
#undef U_MMA
        }
        const int ntok = __builtin_amdgcn_readfirstlane((int)nt_); const bool has_next = ntok < NTOK;
        int e0n = e0, e1n = e1;
        if (has_next) { e0n = exps[(size_t)ntok * 128 + lane]; e1n = exps[(size_t)ntok * 128 + 64 + lane]; }
        asm volatile("s_waitcnt lgkmcnt(0)" ::: "memory");
        const float w0 = gelu_erf(wl[lane] * (1.0f / (H4_SCALE * U_SCALE))) * gates[(size_t)tok * 128 + lane] * (1.0f / V_SCALE);
        const float w1 = gelu_erf(wl[64 + lane] * (1.0f / (H4_SCALE * U_SCALE))) * gates[(size_t)tok * 128 + 64 + lane] * (1.0f / V_SCALE);
        float y[64];
#pragma unroll
        for (int i = 0; i < 64; ++i) y[i] = 0.f;
        for (int slot = 0; slot < 128; ++slot) {
            u32x4 ra, rb; G_READ(ra, rb, rd0 + (unsigned)rs * 2048u);
            if (slot + GR_NS < 128) G_ISSUE(e0, e1, slot + GR_NS, rs); else G_ISSUE(e0n, e1n, slot + GR_NS - 128, rs);
            const float w = rdlane(slot < 64 ? w0 : w1, slot & 63);
#pragma unroll
            for (int q = 0; q < 4; ++q) { float d[8]; tab_dec(ra[q], d);
#pragma unroll
                for (int i = 0; i < 8; ++i) y[q * 8 + i] = fmaf(w, d[i], y[q * 8 + i]); }
#pragma unroll
            for (int q = 0; q < 4; ++q) { float d[8]; tab_dec(rb[q], d);
#pragma unroll
                for (int i = 0; i < 8; ++i) y[32 + q * 8 + i] = fmaf(w, d[i], y[32 + q * 8 + i]); }
            rs = (rs + 1 == GR_NS) ? 0 : rs + 1;
        }
        const bf16_t* op = x2b + (size_t)tok * DM + lane * 32; float* dp = dst + (size_t)tok * DM + lane * 32;
#pragma unroll
        for (int j = 0; j < 2; ++j)
#pragma unroll
            for (int qq = 0; qq < 4; ++qq) {
                f32x4 v0, v1; bf8_f32(*(const u32x4*)(op + j * 2048 + 8 * qq), v0, v1);
#pragma unroll
                for (int i = 0; i < 4; ++i) { v0[i] += y[j * 32 + 8 * qq + i]; v1[i] += y[j * 32 + 8 * qq + 4 + i]; }
                *(f32x4*)(dp + j * 2048 + 8 * qq) = v0; *(f32x4*)(dp + j * 2048 + 8 * qq + 4) = v1;
            }
        e0 = e0n; e1 = e1n; tok = ntok;
    }
    asm volatile("s_waitcnt vmcnt(0)" ::: "memory");
#undef G_ISSUE
#undef G_READ
}
#else
static_assert(TAB_BITS == 4, "the 8-bit-table gather below still reads an f32 x2 from d_out: the residual stream is bf16 now");
__device__ __forceinline__ void peer_gather_phase(const Params& p, float* dst, LAS unsigned char*, int, int wave_gid, int nwaves) {
    constexpr int EPD = 32 / TAB_BITS;
    const int lane = threadIdx.x & 63;
    const unsigned char* u8 = p.ws + WS_P + (size_t)80 * SLAB * 2;
    const unsigned char* v8 = p.ws + (TAB_BITS == 4 ? WS_V4 : WS_HGO);
    const int* exps = (const int*)(p.ws + WS_EXP); const float* gates = (const float*)(p.ws + WS_GATE);
    const unsigned long long* rowss2 = (const unsigned long long*)(p.ws + WS_ROWSS2);
    for (int tok = wave_gid; tok < NTOK; tok += nwaves) {
        const float r2 = rowscale(rowss2, tok) * (1.0f / U_SCALE);
        float h[64];
#pragma unroll
        for (int j = 0; j < G_NJ; ++j)
#pragma unroll
            for (int q = 0; q < G_EPJ / 4; ++q) {
                const f32x4 xv = *(const f32x4*)(p.out + (size_t)tok * DM + j * G_JSTR + lane * G_EPJ + 4 * q), gv = *(const f32x4*)(p.in[I_FFNN] + j * G_JSTR + lane * G_EPJ + 4 * q);
                h[j * G_EPJ + 4 * q] = xv[0] * gv[0] * r2; h[j * G_EPJ + 4 * q + 1] = xv[1] * gv[1] * r2; h[j * G_EPJ + 4 * q + 2] = xv[2] * gv[2] * r2; h[j * G_EPJ + 4 * q + 3] = xv[3] * gv[3] * r2;
                if ((q & 3) == 3) __builtin_amdgcn_sched_barrier(0);
            }
        const int e0 = exps[(size_t)tok * 128 + lane], e1 = exps[(size_t)tok * 128 + 64 + lane];
        const float g0 = gates[(size_t)tok * 128 + lane], g1 = gates[(size_t)tok * 128 + 64 + lane];
        float w0 = 0.f, w1 = 0.f;
        for (int grp = 0; grp < 128 / G_R; ++grp) {
            u32x4 rb[G_R][G_NJ];
#pragma unroll
            for (int r = 0; r < G_R; ++r) {
                const int slot = grp * G_R + r;
                const int e = __builtin_amdgcn_readlane(slot < 64 ? e0 : e1, slot & 63);
                const unsigned char* row = u8 + (size_t)e * TAB_ROW + lane * 16;
#pragma unroll
                for (int j = 0; j < G_NJ; ++j) rb[r][j] = *(const u32x4*)(row + j * 1024);
            }
#pragma unroll
            for (int r = 0; r < G_R; ++r) {
                float acc = 0.f;
#pragma unroll
                for (int j = 0; j < G_NJ; ++j)
#pragma unroll
                    for (int q = 0; q < 4; ++q) {
                        float d[EPD]; tab_dec(rb[r][j][q], d);
#pragma unroll
                        for (int i = 0; i < EPD; ++i) acc = fmaf(d[i], h[j * G_EPJ + q * EPD + i], acc);
                    }
                const float a = wave_allsum(acc);
                const int slot = grp * G_R + r;
                if (slot < 64) { if (lane == (slot & 63)) w0 = a; } else { if (lane == (slot & 63)) w1 = a; }
                __builtin_amdgcn_sched_barrier(0);
            }
        }
        w0 = gelu_erf(w0) * g0 * (1.0f / V_SCALE); w1 = gelu_erf(w1) * g1 * (1.0f / V_SCALE);
        float y[64];
#pragma unroll
        for (int i = 0; i < 64; ++i) y[i] = 0.f;
        for (int grp = 0; grp < 128 / G_R; ++grp) {
            u32x4 rb[G_R][G_NJ];
#pragma unroll
            for (int r = 0; r < G_R; ++r) {
                const int slot = grp * G_R + r;
                const int e = __builtin_amdgcn_readlane(slot < 64 ? e0 : e1, slot & 63);
                const unsigned char* row = v8 + (size_t)e * TAB_ROW + lane * 16;
#pragma unroll
                for (int j = 0; j < G_NJ; ++j) rb[r][j] = *(const u32x4*)(row + j * 1024);
            }
#pragma unroll
            for (int r = 0; r < G_R; ++r) {
                const int slot = grp * G_R + r;
                const float w = rdlane(slot < 64 ? w0 : w1, slot & 63);
#pragma unroll
                for (int j = 0; j < G_NJ; ++j)
#pragma unroll
                    for (int q = 0; q < 4; ++q) {
                        float d[EPD]; tab_dec(rb[r][j][q], d);
#pragma unroll
                        for (int i = 0; i < EPD; ++i) y[j * G_EPJ + q * EPD + i] = fmaf(w, d[i], y[j * G_EPJ + q * EPD + i]);
                    }
                __builtin_amdgcn_sched_barrier(0);
            }
        }
        const float* op = p.out + (size_t)tok * DM + lane * G_EPJ; float* dp = dst + (size_t)tok * DM + lane * G_EPJ;
#pragma unroll
        for (int j = 0; j < G_NJ; ++j)
#pragma unroll
            for (int q = 0; q < G_EPJ / 4; ++q) {
                f32x4 v = *(const f32x4*)(op + j * G_JSTR + 4 * q);
                v[0] += y[j * G_EPJ + 4 * q]; v[1] += y[j * G_EPJ + 4 * q + 1]; v[2] += y[j * G_EPJ + 4 * q + 2]; v[3] += y[j * G_EPJ + 4 * q + 3];
                *(f32x4*)(dp + j * G_JSTR + 4 * q) = v;
            }
    }
}

#endif

#ifndef MIXP
#define MIXP 7
#endif

#ifndef PROJ_F8
#define PROJ_F8 false
#endif
#ifndef MEMKV_IN_P2
#define MEMKV_IN_P2 (N_LAUNCHES == 1)
#endif
#ifndef PROBE_DUP
#define PROBE_DUP 0
#endif
#ifndef DBG_STOP
#define DBG_STOP DBG_DUMP
#endif
#ifndef DBG_SAN
#define DBG_SAN 0
#endif
#ifndef DBG_DUMP
#define DBG_DUMP 11
#endif
#ifndef DBG_SUB
#define DBG_SUB 2
#endif
#ifndef PH_MASK
#define PH_MASK ((2u << DBG_STOP) - 1u)
#endif
constexpr int LDS_ARGS = LDS_MISC + 64;
__device__ __forceinline__ unsigned char* lds_arg(LAS unsigned char* lds, int i) {
    const LAS unsigned* q = (const LAS unsigned*)(lds + LDS_ARGS + 8 * i);
    const unsigned lo = __builtin_amdgcn_readfirstlane(q[0]), hi = __builtin_amdgcn_readfirstlane(q[1]);
    return (unsigned char*)(__attribute__((address_space(1))) unsigned char*)(((unsigned long long)hi << 32) | lo);
}
__device__ __forceinline__ void load_params(LAS unsigned char* lds, Params& p) {
#pragma unroll
    for (int i = 0; i < 27; ++i) p.in[i] = (const float*)lds_arg(lds, i);
    p.out = (float*)lds_arg(lds, 27); p.ws = lds_arg(lds, 28); p.ph_lo = 0; p.ph_hi = 0;
}
__global__ void __launch_bounds__(512, 2) fwd_kernel(Params pk) {
    extern __shared__ __attribute__((aligned(16))) unsigned char lds_raw[];
    LAS unsigned char* lds = (LAS unsigned char*)lds_raw;
    const int tid = threadIdx.x, wid = __builtin_amdgcn_readfirstlane(tid >> 6);
    const int G = gridDim.x, wg = blockIdx.x;
    const int wave_gid = wg * 8 + wid, nwaves = G * 8;
    if (tid == 0) {
        LAS unsigned long long* a = (LAS unsigned long long*)(lds + LDS_ARGS);
#pragma unroll
        for (int i = 0; i < 27; ++i) a[i] = (unsigned long long)pk.in[i];
        a[27] = (unsigned long long)pk.out; a[28] = (unsigned long long)pk.ws; a[29] = ((unsigned long long)(unsigned)pk.ph_hi << 32) | (unsigned)pk.ph_lo;
        LAS unsigned* m = (LAS unsigned*)(lds + LDS_MISC); m[0] = 0u; m[1] = 0u; m[2] = 0u; m[3] = 0u;
    }
    __syncthreads();
    if (N_LAUNCHES == 1) { (void)xcd_barrier_post((unsigned*)(lds_arg(lds, 28) + WS_CTL), (volatile LAS unsigned*)(lds + LDS_MISC)); }
#define GRID_BAR() do { if (N_LAUNCHES == 1) { XcdBarrier bar_; bar_.bar = (unsigned*)(lds_arg(lds, 28) + WS_CTL); bar_.x = xb_xcc_id(); bar_.st = (volatile LAS unsigned*)(lds + LDS_MISC); xcd_barrier(bar_); } } while (0)
#define LOADP() Params p; load_params(lds, p); unsigned char* const ws = p.ws; bf16_t* const Pslab = (bf16_t*)(ws + WS_P); (void)Pslab
    int lo, hi; { const unsigned long long lh = lds_arg(lds, 29) - (unsigned char*)0; lo = (int)(unsigned)lh; hi = (int)(unsigned)(lh >> 32); }
#define IN(k) ((((PH_MASK) >> (k)) & 1) && lo <= (k) && (k) < hi)
#define BOTH(k) (IN(k) && IN((k) + 1))

    if (IN(0)) {
        LOADP();
        for (int rep_ = 0; rep_ < (PROBE_DUP == 100 ? 2 : 1); ++rep_) {
        if (MIXP == 7) transpose_cvt<2>(p.in[I_WIN], DM, IN_COLS, IN_COLS, ws + WS_WIN, DM, 0, W_I8, lds, wg, G);
        else if (MIXP == 6) { transpose_cvt<false>(p.in[I_WIN], DM, 6144, IN_COLS, ws + WS_WIN, DM, 0, 1.f, lds, wg, G);
                         transpose_cvt<true>(p.in[I_WIN] + 6144, DM, 8192, IN_COLS, ws + WS_WIN8E, DM, 0, W_SCALE, lds, wg, G); }
        else if (MIXP == 5) { transpose_cvt<false>(p.in[I_WIN], DM, 8192, IN_COLS, ws + WS_WIN, DM, 0, 1.f, lds, wg, G);
                         transpose_cvt<false>(p.in[I_WIN] + 10240, DM, 4096, IN_COLS, ws + WS_WIN, DM, 8192, 1.f, lds, wg, G);
                         transpose_cvt<true>(p.in[I_WIN] + 8192, DM, 2048, IN_COLS, ws + WS_WIN8D, DM, 0, W_SCALE, lds, wg, G); }
        else if (MIXP == 4) { transpose_cvt<false>(p.in[I_WIN] + 8192, DM, 2048, IN_COLS, ws + WS_WIN, DM, 0, 1.f, lds, wg, G);
                         transpose_cvt<true>(p.in[I_WIN], DM, 8192, IN_COLS, ws + WS_WIN8C, DM, 0, W_SCALE, lds, wg, G);
                         transpose_cvt<true>(p.in[I_WIN] + 10240, DM, 4096, IN_COLS, ws + WS_WIN8C, DM, 8192, W_SCALE, lds, wg, G); }
        else if (MIXP == 3) { transpose_cvt<false>(p.in[I_WIN] + 4096, DM, 10240, IN_COLS, ws + WS_WIN, DM, 0, 1.f, lds, wg, G);
                         transpose_cvt<true>(p.in[I_WIN], DM, 4096, IN_COLS, ws + WS_WIN8B, DM, 0, W_SCALE, lds, wg, G); }
        else if (MIXP == 2) transpose_cvt<true>(p.in[I_WIN], DM, IN_COLS, IN_COLS, ws + WS_WIN, DM, 0, W_SCALE, lds, wg, G);
        else if (MIXP == 1) {
            const float* wi = p.in[I_WIN];
            transpose_cvt<false>(wi + 2 * 2048, DM, 2048, IN_COLS, ws + WS_WIN, DM, 0, 1.f, lds, wg, G);
            transpose_cvt<false>(wi + 3 * 2048, DM, 2048, IN_COLS, ws + WS_WIN, DM, 2048, 1.f, lds, wg, G);
            transpose_cvt<false>(wi + 5 * 2048, DM, 2048, IN_COLS, ws + WS_WIN, DM, 4096, 1.f, lds, wg, G);
            transpose_cvt<false>(wi + 6 * 2048, DM, 2048, IN_COLS, ws + WS_WIN, DM, 6144, 1.f, lds, wg, G);
            transpose_cvt<true>(wi + 0 * 2048, DM, 2048, IN_COLS, ws + WS_WIN8, DM, 0, W_SCALE, lds, wg, G);
            transpose_cvt<true>(wi + 1 * 2048, DM, 2048, IN_COLS, ws + WS_WIN8, DM, 2048, W_SCALE, lds, wg, G);
            transpose_cvt<true>(wi + 4 * 2048, DM, 2048, IN_COLS, ws + WS_WIN8, DM, 4096, W_SCALE, lds, wg, G);
        } else transpose_cvt<false>(p.in[I_WIN], DM, IN_COLS, IN_COLS, ws + WS_WIN, DM, 0, 1.f, lds, wg, G);
        transpose_cvt<WO_MODE>(p.in[I_WOUT], DM, DM, DM, ws + WS_WOUT, DM, 0, WO_MODE == 2 ? W_I8 : 1.f, lds, wg, G);
        transpose_cvt<MQ_MODE>(p.in[I_WMQ], DM, 512, 512, ws + WS_WMQ, DM, 0, MQ_MODE == 2 ? W_I8 : (MQ_MODE == 1 ? W_SCALE : 1.f), lds, wg, G);
        transpose_cvt<2>(p.in[I_WMK], DM, 512, 512, ws + WS_WMKV, DM, 0, W_I8, lds, wg, G);
        transpose_cvt<2>(p.in[I_WMV], DM, 512, 512, ws + WS_WMKV, DM, 512, W_I8, lds, wg, G);
        transpose_cvt<false>(p.in[I_WMO], 512, DM, DM, ws + WS_WMO, 512, 0, 1.f, lds, wg, G);
        transpose_cvt<PQ_MODE, PQ_MODE == 0>(p.in[I_PWQ], DM, 2048, 2048, ws + WS_WPQ, DM, 0, PQ_MODE == 2 ? W_I8 : (PQ_MODE == 1 ? W_SCALE : 1.f), lds, wg, G, p.in[I_FFNN]);
        if (MIXP == 7) rmsnorm_rows_i8(p.in[I_X], p.in[I_MIXN], ws + WS_HGO, NTOK, wave_gid, nwaves, lds);
        else rmsnorm_rows<MIXP == 7 ? 3 : (MIXP == 2 ? 1 : (MIXP == 1 || MIXP >= 3 ? 2 : 0))>(p.in[I_X], p.in[I_MIXN], (MIXP == 2 || MIXP == 7) ? ws + WS_HGO : ws + WS_A, ws + WS_HGO, NTOK, wave_gid, nwaves);
        rmsnorm_rows_i8(p.in[I_MEM], p.in[I_MEMKVN], ws + WS_MEMN, NMEM, wave_gid, nwaves, lds);
        { bf16_t* kd = (bf16_t*)(ws + WS_KEYS); const float* ks = p.in[I_PKEYS];
          for (int i = wg * 512 + tid; i < 8 * 2 * 128 * 128; i += G * 512) kd[i] = f2bf(ks[i]); }
        }
        if (BOTH(0)) GRID_BAR();
    }
    if (IN(1)) {
        LOADP();
        if (MIXP == 7) {
            pg8::Gemm g{ws + WS_HGO, ws + WS_WIN, NTOK, IN_COLS, DM, DM, DM}; pg8::StaticOrder S; S.init(NTOK, IN_COLS, G, wg);
            pg8::EpiBf16S E{Pslab, nullptr, 1, SLAB, 0, 1.0f / (H_I8 * W_I8), 1 << 30, 0, 0, p.in[I_DKN], SL_DK, SL_DK + 16, (LAS float*)(lds + KN_LDS)};
            pg8::gemm_phase<pg8::EpiBf16S, 2>(lds, g, S, E);
        } else if (MIXP == 6) {
            { pg8::Gemm g{ws + WS_A, ws + WS_WIN, NTOK, 6144, DM, DM * 2, DM * 2}; pg8::StaticOrder S; S.init(NTOK, 6144, G, wg);
              pg8::EpiBf16S E{Pslab, nullptr, 1, SLAB, 0, 1.0f, 1 << 30, 0, 0};
              pg8::gemm_phase<pg8::EpiBf16S, false>(lds, g, S, E); }
            { pg8::Gemm g{ws + WS_HGO, ws + WS_WIN8E, NTOK, 8192, DM, DM, DM}; pg8::StaticOrder S; S.init(NTOK, 8192, G, wg);
              pg8::EpiBf16S E{Pslab, nullptr, 1, SLAB, 0, 1.0f / (H_SCALE * W_SCALE), 1 << 30, 48, 48};
              pg8::gemm_phase<pg8::EpiBf16S, true>(lds, g, S, E); }
        } else if (MIXP == 5) {
            { pg8::Gemm g{ws + WS_A, ws + WS_WIN, NTOK, 12288, DM, DM * 2, DM * 2}; pg8::StaticOrder S; S.init(NTOK, 12288, G, wg);
              pg8::EpiBf16S E{Pslab, nullptr, 1, SLAB, 0, 1.0f, 64, 0, 16};
              pg8::gemm_phase<pg8::EpiBf16S, false>(lds, g, S, E); }
            { pg8::Gemm g{ws + WS_HGO, ws + WS_WIN8D, NTOK, 2048, DM, DM, DM}; pg8::StaticOrder S; S.init(NTOK, 2048, G, wg);
              pg8::EpiBf16S E{Pslab, nullptr, 1, SLAB, 0, 1.0f / (H_SCALE * W_SCALE), 1 << 30, 64, 64};
              pg8::gemm_phase<pg8::EpiBf16S, true>(lds, g, S, E); }
        } else if (MIXP == 4) {
            { pg8::Gemm g{ws + WS_A, ws + WS_WIN, NTOK, 2048, DM, DM * 2, DM * 2}; pg8::StaticOrder S; S.init(NTOK, 2048, G, wg);
              pg8::EpiBf16S E{Pslab, nullptr, 1, SLAB, 0, 1.0f, 1 << 30, 64, 64};
              pg8::gemm_phase<pg8::EpiBf16S, false>(lds, g, S, E); }
            { pg8::Gemm g{ws + WS_HGO, ws + WS_WIN8C, NTOK, 12288, DM, DM, DM}; pg8::StaticOrder S; S.init(NTOK, 12288, G, wg);
              pg8::EpiBf16S E{Pslab, nullptr, 1, SLAB, 0, 1.0f / (H_SCALE * W_SCALE), 64, 0, 16};
              pg8::gemm_phase<pg8::EpiBf16S, true>(lds, g, S, E); }
        } else if (MIXP == 3) {
            { pg8::Gemm g{ws + WS_A, ws + WS_WIN, NTOK, 10240, DM, DM * 2, DM * 2}; pg8::StaticOrder S; S.init(NTOK, 10240, G, wg);
              pg8::EpiBf16S E{Pslab, nullptr, 1, SLAB, 0, 1.0f, 1 << 30, 32, 32};
              pg8::gemm_phase<pg8::EpiBf16S, false>(lds, g, S, E); }
            { pg8::Gemm g{ws + WS_HGO, ws + WS_WIN8B, NTOK, 4096, DM, DM, DM}; pg8::StaticOrder S; S.init(NTOK, 4096, G, wg);
              pg8::EpiBf16S E{Pslab, nullptr, 1, SLAB, 0, 1.0f / (H_SCALE * W_SCALE), 1 << 30, 0, 0};
              pg8::gemm_phase<pg8::EpiBf16S, true>(lds, g, S, E); }
        } else if (MIXP == 2) {
            pg8::Gemm g{ws + WS_HGO, ws + WS_WIN, NTOK, IN_COLS, DM, DM, DM}; pg8::StaticOrder S; S.init(NTOK, IN_COLS, G, wg);
            pg8::EpiBf16S E{Pslab, nullptr, 1, SLAB, 0, 1.0f / (H_SCALE * W_SCALE), 1 << 30, 0, 0};
            pg8::gemm_phase<pg8::EpiBf16S, true>(lds, g, S, E);
        } else if (MIXP == 1) {
            { pg8::Gemm g{ws + WS_A, ws + WS_WIN, NTOK, 8192, DM, DM * 2, DM * 2}; pg8::StaticOrder S; S.init(NTOK, 8192, G, wg);
              pg8::EpiBf16S E{Pslab, nullptr, 1, SLAB, 0, 1.0f, 32, 32, 48};
              pg8::gemm_phase<pg8::EpiBf16S, false>(lds, g, S, E); }
            { pg8::Gemm g{ws + WS_HGO, ws + WS_WIN8, NTOK, 6144, DM, DM, DM}; pg8::StaticOrder S; S.init(NTOK, 6144, G, wg);
              pg8::EpiBf16S E{Pslab, nullptr, 1, SLAB, 0, 1.0f / (H_SCALE * W_SCALE), 32, 0, 32};
              pg8::gemm_phase<pg8::EpiBf16S, true>(lds, g, S, E); }
        } else {
            pg8::Gemm g{ws + WS_A, ws + WS_WIN, NTOK, IN_COLS, DM, DM * 2, DM * 2}; pg8::StaticOrder S; S.init(NTOK, IN_COLS, G, wg);
            pg8::EpiBf16S E{Pslab, nullptr, 1, SLAB, 0, 1.0f, 1 << 30, 0, 0};
            pg8::gemm_phase<pg8::EpiBf16S, false>(lds, g, S, E);
        }
        if (!MEMKV_IN_P2 || MIXP != 7 || G < 32) {
          pg8::Gemm g{ws + WS_MEMN, ws + WS_WMKV, NMEM, 1024, DM, DM, DM}; pg8::StaticOrder S; S.init(NMEM, 1024, G, wg);
          pg8::EpiBf16S E{(bf16_t*)(ws + WS_MEMKV), nullptr, 1, (size_t)NMEM * 128, 0, 1.0f / (H_I8 * W_I8), 1 << 30, 0, 0, p.in[I_MKN], 0, 4, (LAS float*)(lds + KN_LDS)};
          pg8::gemm_phase<pg8::EpiBf16S, 2>(lds, g, S, E);
          if (TAB_BITS == 4 && wg >= 16) cvt_fp8_table(p.in[I_PV], ws + WS_V4, V_SCALE, (wg - 16) * 512 + tid, (G - 16) * 512);
        } else if (TAB_BITS == 4) cvt_fp8_table(p.in[I_PV], ws + WS_V4, V_SCALE, wg * 512 + tid, G * 512);
        if (BOTH(1)) GRID_BAR();
    }
    if (IN(2)) {
        LOADP();
        if (MIXP != 7) { knorm_rows(Pslab + (size_t)SL_DK * SLAB, (size_t)16 * NTOK, p.in[I_DKN], wave_gid, nwaves);
                         knorm_rows((bf16_t*)(ws + WS_MEMKV), (size_t)4 * NMEM, p.in[I_MKN], wave_gid, nwaves); }
        if (MEMKV_IN_P2 && MIXP == 7 && G >= 32) {
            if (wg < 16) { pg8::Gemm g{ws + WS_MEMN, ws + WS_WMKV, NMEM, 1024, DM, DM, DM}; pg8::StaticOrder S; S.init(NMEM, 1024, 16, wg);
                pg8::EpiBf16S E{(bf16_t*)(ws + WS_MEMKV), nullptr, 1, (size_t)NMEM * 128, 0, 1.0f / (H_I8 * W_I8), 1 << 30, 0, 0, p.in[I_MKN], 0, 4, (LAS float*)(lds + KN_LDS)};
                pg8::gemm_phase<pg8::EpiBf16S, 2>(lds, g, S, E); }
            else hgrn_prepass(p, lds, wg - 16, G - 16);
        } else hgrn_prepass(p, lds, wg, G);
        if (BOTH(2)) GRID_BAR();
    }
    if (IN(3)) {
        LOADP();
        for (int rep_ = 0; rep_ < (PROBE_DUP == 31 ? 2 : 1); ++rep_)
        for (int u = wg; u < 256; u += G) { const int uu = (G == 256) ? ((((u >> 5) * 8 + (u & 7)) << 2) | ((u >> 3) & 3)) : u;
            hgrn_unit(p, uu, lds); __syncthreads(); }
        diff_attn_phase(p, (char*)lds_raw, lds);
        if (BOTH(3)) GRID_BAR();
    }
    if (IN(4)) {
        LOADP();
        mixfinal_phase(p, wave_gid, nwaves);
        if (BOTH(4)) GRID_BAR();
    }
    if (IN(5)) {
        LOADP();
        pg8::Gemm g{ws + WS_P, ws + WS_WOUT, NTOK, DM, DM, DM * (WO_MODE == 2 ? 1 : 2), DM * (WO_MODE == 2 ? 1 : 2)}; pg8::StaticOrder S; S.init(NTOK, DM, G, wg);
        pg8::EpiResid<MQ_MODE, false> E{p.in[I_X], Pslab + (size_t)32 * SLAB, ws + WS_A, p.in[I_MEMN], (unsigned long long*)(ws + WS_ROWSS1), WO_MODE == 2 ? 1.0f / (MIX_I8 * W_I8) : 1.0f};
        pg8::gemm_phase<pg8::EpiResid<MQ_MODE, false>, WO_MODE>(lds, g, S, E);
        if (BOTH(5)) GRID_BAR();
    }
    if (IN(6)) {
        LOADP();
        constexpr int EB = MQ_MODE != 0 ? 1 : 2;
        pg8::Gemm g{ws + WS_A, ws + WS_WMQ, NTOK, 512, DM, DM * EB, DM * EB}; pg8::StaticOrder S; S.init(NTOK, 512, G, wg);
        pg8::EpiBf16S E{(bf16_t*)(ws + WS_QMEM), (const unsigned long long*)(ws + WS_ROWSS1), 1, SLAB, 0, MQ_MODE == 2 ? 1.0f / (XG_I8 * W_I8) : (MQ_MODE == 1 ? 1.0f / (XG_SCALE * W_SCALE) : 1.0f), 1 << 30, 0, 0};
        pg8::gemm_phase<pg8::EpiBf16S, MQ_MODE>(lds, g, S, E);
        if (TAB_BITS == 4 && wg >= 128) cvt_fp8_table(p.in[I_PU], ws + WS_P + (size_t)80 * SLAB * 2, U_SCALE, (wg - 128) * 512 + tid, (G - 128) * 512);
        if (BOTH(6)) GRID_BAR();
    }
    if (IN(7)) {
        LOADP();
        mem_attn_phase(p, (char*)lds_raw);
        if (TAB_BITS != 4) { cvt_fp8_table(p.in[I_PU], ws + WS_P + (size_t)80 * SLAB * 2, U_SCALE, wg * 512 + tid, G * 512);
                             cvt_fp8_table(p.in[I_PV], ws + WS_HGO, V_SCALE, wg * 512 + tid, G * 512); }
        if (BOTH(7)) GRID_BAR();
    }
    if (IN(8)) {
        LOADP();
        pg8::Gemm g{ws + WS_OMEM, ws + WS_WMO, NTOK, DM, 512, 1024, 1024}; pg8::StaticOrder S; S.init(NTOK, DM, G, wg);
        constexpr int G8_ = PQ_MODE != 0 ? PQ_MODE : -1;
        pg8::EpiResid<G8_, true> E{Pslab + (size_t)32 * SLAB, Pslab, ws + WS_A, p.in[I_FFNN], (unsigned long long*)(ws + WS_ROWSS2), 1.0f};
        pg8::gemm_phase<pg8::EpiResid<G8_, true>, false>(lds, g, S, E);
        if (BOTH(8)) GRID_BAR();
    }
    if (IN(9)) {
        LOADP();
        constexpr int EB = PQ_MODE != 0 ? 1 : 2;
        pg8::Gemm g{PQ_MODE != 0 ? (const void*)(ws + WS_A) : (const void*)Pslab, ws + WS_WPQ, NTOK, 2048, DM, DM * EB, DM * EB}; pg8::StaticOrder S; S.init(NTOK, 2048, G, wg);
        pg8::EpiBf16S E{Pslab + (size_t)64 * SLAB, (const unsigned long long*)(ws + WS_ROWSS2), 0, 0, 2048, PQ_MODE == 2 ? 1.0f / (XG_I8 * W_I8) : (PQ_MODE == 1 ? 1.0f / (XG_SCALE * W_SCALE) : 1.0f), 1 << 30, 0, 0};
        pg8::gemm_phase<pg8::EpiBf16S, PQ_MODE>(lds, g, S, E);
        if (BOTH(9)) GRID_BAR();
    }
    if (IN(10)) {
        LOADP();
        peer_topk_phase(p, lds, wid, wave_gid, nwaves);
        if (BOTH(10)) GRID_BAR();
    }
    if (IN(11)) {
        LOADP();
#if PROBE_DUP == 11
        peer_gather_phase(p, (float*)(ws + WS_A), lds, wid, wave_gid, nwaves);
#endif
        peer_gather_phase(p, p.out, lds, wid, wave_gid, nwaves);
    }
#if DBG_SAN
    if (hi == NPHASE + 1) {
        LOADP();
        const size_t n = (size_t)NTOK * DM;
        for (size_t i = (size_t)wg * 512 + tid; i < n; i += (size_t)G * 512) {
            const size_t tok = i / DM; const int c = (int)(i % DM);
            float v;
#if DBG_DUMP == 0
            v = bf2f(((const bf16_t*)(ws + WS_A))[i]);
#elif DBG_DUMP == 1 || DBG_DUMP == 2
            v = 0.f;
            for (int g = 0; g < 4; ++g) { const int sl = 32 * g + c / 128; if (sl < NSLAB) v += bf2f(Pslab[(size_t)sl * SLAB + tok * 128 + (c & 127)]); }
#elif DBG_DUMP == 3
            v = 0.f;
            if (DBG_SUB != 2) v = bf2f(((const bf16_t*)(ws + WS_A))[(size_t)(c / 128) * SLAB + tok * 128 + (c & 127)]);
            if (DBG_SUB != 1 && c < 2048) v += bf2f(((const bf16_t*)(ws + WS_HGO))[tok * 2048 + c]);
#elif DBG_DUMP == 4
            v = bf2f(Pslab[i]);
#else
            v = (DBG_STOP < 5) ? p.in[I_X][i] : p.out[i];
#endif
            if (!(fabsf(v) < 1e30f)) v = 100.f;
            p.out[i] = v;
        }
    }
#endif
#undef IN
#undef BOTH
#undef GRID_BAR
}

extern "C" void kernel_launch(void* const* d_in, const int* in_sizes, int n_in, void* d_out, int out_size, void* d_ws, size_t ws_size, hipStream_t stream) {
    static int grid = 0;
    if (grid == 0) {
        if (n_in != 27 || out_size != NTOK * DM || ws_size < WS_END2) { fprintf(stderr, "kernel_launch: unexpected shapes (n_in %d out %d ws %zu need %zu)\n", n_in, out_size, ws_size, (size_t)WS_END2); grid = -1; return; }
        int dev = 0, cus = 0, per_cu = 0;
        if (hipGetDevice(&dev) != hipSuccess || hipDeviceGetAttribute(&cus, hipDeviceAttributeMultiprocessorCount, dev) != hipSuccess) { grid = -1; return; }
        if (hipFuncSetAttribute((const void*)fwd_kernel, hipFuncAttributeMaxDynamicSharedMemorySize, LDS_BYTES) != hipSuccess) { fprintf(stderr, "kernel_launch: hipFuncSetAttribute failed\n"); grid = -1; return; }
        if (hipOccupancyMaxActiveBlocksPerMultiprocessor(&per_cu, (const void*)fwd_kernel, 512, LDS_BYTES) != hipSuccess || per_cu < 1) { fprintf(stderr, "kernel_launch: occupancy query says %d\n", per_cu); (void)hipGetLastError(); per_cu = 1; }
        grid = cus;
    }
    if (grid < 0) return;
    (void)hipMemsetAsync((char*)d_ws + WS_CTL, 0, CTL_ZERO_BYTES, stream);
    Params p{};
    for (int i = 0; i < 27; ++i) p.in[i] = (const float*)d_in[i];
    p.out = (float*)d_out; p.ws = (unsigned char*)d_ws;
    if (N_LAUNCHES == 1) {
        p.ph_lo = 0; p.ph_hi = NPHASE;
        hipLaunchKernelGGL(fwd_kernel, dim3(grid), dim3(512), LDS_BYTES, stream, p);
    } else {
        for (int k = 0; k < NPHASE + (DBG_SAN ? 1 : 0); ++k) { p.ph_lo = k; p.ph_hi = k + 1; hipLaunchKernelGGL(fwd_kernel, dim3(grid), dim3(512), LDS_BYTES, stream, p); }
    }
}
```
